# Optimizing an MI355X kernel written in HIP

```python
import jax, jax.numpy as jnp
from jax import lax
import numpy as np

D_MODEL = 1024
BATCH = 8
SEQ = 4096
DEPTH = 2

N_MIXERS = 2
FNET_GROUPS = 8
FNET_GROUP_DIM = D_MODEL // FNET_GROUPS
HEAD_DIM = 64
N_HEADS = D_MODEL // HEAD_DIM
N_KV_HEADS = 4
Q_PER_KV = N_HEADS // N_KV_HEADS
WINDOW = 128
ATTN_BLOCK = 128
ROPE_THETA = 10000.0
N_EXPERTS = 32
TOP_K = 4
D_FF = D_MODEL
SWIGLU_ALPHA = 1.702
SWIGLU_LIMIT = 7.0
MOE_BLOCK = 128
RMS_EPS = 1e-5
NEG_INF = -1e30
N_FNET_LAYERS = (DEPTH + 1) // 2
N_ATTN_LAYERS = DEPTH // 2

kernel_name = 'hybrid_fnet_swa_moe_encoder'


def rms_norm(x, g):
    xf = x.astype(jnp.float32)
    y = xf * lax.rsqrt(jnp.mean(xf * xf, axis=-1, keepdims=True) + RMS_EPS)
    return (y * g.astype(jnp.float32)).astype(x.dtype)


def fourier_mixer(h, w_o, b_o):
    B, S, D = h.shape
    hg = h.astype(jnp.float32).reshape(B, S, FNET_GROUPS, FNET_GROUP_DIM)
    mixed = jnp.fft.fft2(hg, axes=(1, 3), norm='ortho').real
    mixed = mixed.reshape(B, S, D).astype(h.dtype)
    return mixed @ w_o + b_o


def apply_rope(t, cos, sin):
    t1, t2 = jnp.split(t, 2, axis=-1)
    c = cos[None, :, None, :]
    s = sin[None, :, None, :]
    return jnp.concatenate([t1 * c - t2 * s, t2 * c + t1 * s], axis=-1)


def window_attention(h, w_qkv, b_qkv, sink, w_o, b_o):
    B, S, _ = h.shape
    nq = S // ATTN_BLOCK
    qkv = h @ w_qkv + b_qkv
    q, k, v = jnp.split(qkv, [N_HEADS * HEAD_DIM, (N_HEADS + N_KV_HEADS) * HEAD_DIM], axis=-1)
    q = q.reshape(B, S, N_HEADS, HEAD_DIM)
    k = k.reshape(B, S, N_KV_HEADS, HEAD_DIM)
    v = v.reshape(B, S, N_KV_HEADS, HEAD_DIM)
    pos = jnp.arange(S, dtype=jnp.float32)
    inv_freq = ROPE_THETA ** (-jnp.arange(0, HEAD_DIM, 2, dtype=jnp.float32) / HEAD_DIM)
    ang = pos[:, None] * inv_freq[None, :]
    cos = jnp.cos(ang).astype(h.dtype)
    sin = jnp.sin(ang).astype(h.dtype)
    q = apply_rope(q, cos, sin)
    k = apply_rope(k, cos, sin)
    qb = jnp.moveaxis(q.reshape(B, nq, ATTN_BLOCK, N_KV_HEADS, Q_PER_KV, HEAD_DIM), 1, 0)

    def band(t):
        tb = t.reshape(B, nq, ATTN_BLOCK, N_KV_HEADS, HEAD_DIM)
        tp = jnp.pad(tb, ((0, 0), (1, 1), (0, 0), (0, 0), (0, 0)))
        cat = jnp.concatenate([tp[:, :-2], tp[:, 1:-1], tp[:, 2:]], axis=2)
        return jnp.moveaxis(cat, 1, 0)

    kb = band(k)
    vb = band(v)
    blk = jnp.arange(nq)[:, None, None]
    qpos = blk * ATTN_BLOCK + jnp.arange(ATTN_BLOCK)[None, :, None]
    kpos = (blk - 1) * ATTN_BLOCK + jnp.arange(3 * ATTN_BLOCK)[None, None, :]
    mask = (jnp.abs(qpos - kpos) <= WINDOW) & (kpos >= 0) & (kpos < S)
    sink_l = sink.astype(jnp.float32).reshape(1, N_KV_HEADS, Q_PER_KV, 1, 1)
    scale = HEAD_DIM ** -0.5

    def attend(args):
        q_blk, k_blk, v_blk, m_blk = args
        s = jnp.einsum('bqkgd,bpkd->bkgqp', q_blk, k_blk).astype(jnp.float32) * scale
        s = jnp.where(m_blk[None, None, None], s, NEG_INF)
        mx = jnp.maximum(jnp.max(s, axis=-1, keepdims=True), sink_l)
        p = jnp.exp(s - mx)
        denom = jnp.sum(p, axis=-1, keepdims=True) + jnp.exp(sink_l - mx)
        probs = (p / denom).astype(v_blk.dtype)
        return jnp.einsum('bkgqp,bpkd->bqkgd', probs, v_blk)

    o = lax.map(attend, (qb, kb, vb, mask))
    o = jnp.moveaxis(o, 0, 1).reshape(B, S, N_HEADS * HEAD_DIM)
    return o @ w_o + b_o


def moe_ffn(h, router_w, router_b, w_gu, b_gu, w_down, b_down):
    B, S, D = h.shape
    T = B * S
    xt = h.reshape(T, D)
    logits = xt.astype(jnp.float32) @ router_w.astype(jnp.float32) + router_b.astype(jnp.float32)
    top_vals, top_idx = lax.top_k(logits, TOP_K)
    gates = jax.nn.softmax(top_vals, axis=-1)
    A = T * TOP_K
    flat_e = top_idx.reshape(A)
    flat_tok = jnp.arange(A, dtype=jnp.int32) // TOP_K
    order = jnp.argsort(flat_e, stable=True)
    sorted_e = flat_e[order]
    sorted_tok = flat_tok[order]
    sorted_gate = gates.reshape(A)[order]
    counts = jnp.bincount(flat_e, length=N_EXPERTS)
    padded = ((counts + MOE_BLOCK - 1) // MOE_BLOCK) * MOE_BLOCK
    starts = jnp.cumsum(counts) - counts
    pend = jnp.cumsum(padded)
    pstarts = pend - padded
    rank = jnp.arange(A, dtype=jnp.int32) - starts[sorted_e]
    dest = pstarts[sorted_e] + rank
    n_slots = A + N_EXPERTS * MOE_BLOCK
    n_blocks = n_slots // MOE_BLOCK
    slot_tok = jnp.full((n_slots,), T, dtype=jnp.int32).at[dest].set(sorted_tok)
    x_pad = jnp.concatenate([xt, jnp.zeros((1, D), xt.dtype)], axis=0)
    xs = x_pad[slot_tok].reshape(n_blocks, MOE_BLOCK, D)
    block_start = jnp.arange(n_blocks, dtype=jnp.int32) * MOE_BLOCK
    block_expert = jnp.clip(jnp.searchsorted(pend, block_start, side='right'), 0, N_EXPERTS - 1)

    def expert_block(args):
        xb, e = args
        gu = xb @ w_gu[e] + b_gu[e]
        gate, up = jnp.split(gu, 2, axis=-1)
        gate = jnp.minimum(gate, SWIGLU_LIMIT)
        up = jnp.clip(up, -SWIGLU_LIMIT, SWIGLU_LIMIT)
        glu = gate * jax.nn.sigmoid(gate * SWIGLU_ALPHA)
        return ((up + 1) * glu) @ w_down[e] + b_down[e]

    ys = lax.map(expert_block, (xs, block_expert)).reshape(n_slots, D)
    y_assign = ys[dest] * sorted_gate[:, None].astype(ys.dtype)
    out = jax.ops.segment_sum(y_assign, sorted_tok, num_segments=T)
    return out.reshape(B, S, D).astype(h.dtype)


def setup_inputs(seed: int = 0) -> dict:
    key = jax.random.key(seed)
    ks = jax.random.split(key, 18)
    f32 = jnp.float32
    qkv_dim = (N_HEADS + 2 * N_KV_HEADS) * HEAD_DIM
    nrm = lambda k, shape, s: jax.random.normal(k, shape, f32) * s
    return {
        'x': nrm(ks[0], (BATCH, SEQ, D_MODEL), 1.0),
        'norm_mix_g': 1.0 + nrm(ks[1], (DEPTH, D_MODEL), 0.02),
        'norm_ffn_g': 1.0 + nrm(ks[2], (DEPTH, D_MODEL), 0.02),
        'fnet_w_o': nrm(ks[3], (N_FNET_LAYERS, D_MODEL, D_MODEL), D_MODEL ** -0.5),
        'fnet_b_o': nrm(ks[4], (N_FNET_LAYERS, D_MODEL), 0.02),
        'attn_w_qkv': nrm(ks[5], (N_ATTN_LAYERS, D_MODEL, qkv_dim), D_MODEL ** -0.5),
        'attn_b_qkv': nrm(ks[6], (N_ATTN_LAYERS, qkv_dim), 0.02),
        'attn_sink': nrm(ks[7], (N_ATTN_LAYERS, N_HEADS), 0.5),
        'attn_w_o': nrm(ks[8], (N_ATTN_LAYERS, N_HEADS * HEAD_DIM, D_MODEL), (N_HEADS * HEAD_DIM) ** -0.5),
        'attn_b_o': nrm(ks[9], (N_ATTN_LAYERS, D_MODEL), 0.02),
        'router_w': nrm(ks[10], (DEPTH, D_MODEL, N_EXPERTS), D_MODEL ** -0.5),
        'router_b': nrm(ks[11], (DEPTH, N_EXPERTS), 0.01),
        'expert_w_gu': nrm(ks[12], (DEPTH, N_EXPERTS, D_MODEL, 2 * D_FF), D_MODEL ** -0.5),
        'expert_b_gu': nrm(ks[13], (DEPTH, N_EXPERTS, 2 * D_FF), 0.02),
        'expert_w_down': nrm(ks[14], (DEPTH, N_EXPERTS, D_FF, D_MODEL), D_FF ** -0.5),
        'expert_b_down': nrm(ks[15], (DEPTH, N_EXPERTS, D_MODEL), 0.02),
        'final_norm_g': 1.0 + nrm(ks[16], (D_MODEL,), 0.02),
    }


def reference(x, norm_mix_g, norm_ffn_g, fnet_w_o, fnet_b_o, attn_w_qkv, attn_b_qkv, attn_sink, attn_w_o, attn_b_o, router_w, router_b, expert_w_gu, expert_b_gu, expert_w_down, expert_b_down, final_norm_g):
    for i in range(DEPTH):
        h = rms_norm(x, norm_mix_g[i])
        j = i // N_MIXERS
        if i % N_MIXERS == 0:
            mix = fourier_mixer(h, fnet_w_o[j], fnet_b_o[j])
        else:
            mix = window_attention(h, attn_w_qkv[j], attn_b_qkv[j], attn_sink[j], attn_w_o[j], attn_b_o[j])
        x = x + mix
        h = rms_norm(x, norm_ffn_g[i])
        x = x + moe_ffn(h, router_w[i], router_b[i], expert_w_gu[i], expert_b_gu[i], expert_w_down[i], expert_b_down[i])
    return rms_norm(x, final_norm_g)
```

```cpp
#include <hip/hip_runtime.h>
#include <cstdio>
#include <cstdint>

#define LAS __attribute__((address_space(3)))
#define DEVI __device__ __forceinline__
typedef unsigned short bf16_t;
typedef short bf16x8 __attribute__((ext_vector_type(8)));
typedef short s16x4 __attribute__((ext_vector_type(4)));
typedef float f32x2 __attribute__((ext_vector_type(2)));
typedef float f32x4 __attribute__((ext_vector_type(4)));
typedef float f32x16 __attribute__((ext_vector_type(16)));
typedef unsigned u32x2 __attribute__((ext_vector_type(2)));
typedef unsigned u32x4 __attribute__((ext_vector_type(4)));
typedef int i32x4 __attribute__((ext_vector_type(4)));
typedef int i32x8 __attribute__((ext_vector_type(8)));
typedef __bf16 bf16x2_t __attribute__((ext_vector_type(2)));

#define PG8_BUILTIN_DMA 0
#ifndef MK_N_LAUNCHES
#define MK_N_LAUNCHES 1
#endif
constexpr int NPHASE = 16;

constexpr int D = 1024, BATCH = 8, SEQ = 4096, T = BATCH * SEQ, NE = 32, TOPK = 4, QKVD = 1536, NH = 16;
constexpr int MT = 256, NSLOT = T * TOPK + NE * MT, NTILE = NSLOT / MT;
constexpr float RMS_EPS = 1e-5f;

constexpr size_t MiB = 1u << 20;
constexpr size_t WS_CTL = 0, CTL_ZERO_BYTES = 128 * 1024;
constexpr size_t WS_WGU = 2 * MiB;
constexpr size_t WS_WD = WS_WGU + 256 * MiB;
constexpr size_t WS_WP = WS_WD + 128 * MiB;
constexpr size_t WS_WQKV = WS_WP + 4 * MiB;
constexpr size_t WS_WO = WS_WQKV + 3 * MiB;
constexpr size_t WS_CS = WS_WO + 3 * MiB;
constexpr size_t WS_XB = WS_CS;
constexpr size_t WS_HT = WS_CS + 64 * MiB;
constexpr size_t WS_A2 = WS_HT + 64 * MiB;
constexpr size_t WS_UB = WS_A2, WS_VB = WS_A2 + 32 * MiB, WS_U2048 = WS_A2 + 64 * MiB;
constexpr size_t WS_HN = WS_A2 + 128 * MiB;
constexpr size_t WS_HN8 = WS_HN + 64 * MiB;
constexpr size_t WS_XS = WS_HN8 + 64 * MiB;
constexpr size_t WS_HID = WS_XS + 272 * MiB;
constexpr size_t WS_Y = WS_HID + 272 * MiB;
constexpr size_t WS_Q = WS_Y + 272 * MiB;
constexpr size_t WS_K = WS_Q + 64 * MiB;
constexpr size_t WS_VT = WS_K + 16 * MiB;
constexpr size_t WS_O = WS_VT + 16 * MiB;
constexpr size_t WS_IDX = WS_O + 64 * MiB;
constexpr size_t WS_GATE = WS_IDX + 1 * MiB;
constexpr size_t WS_RANK = WS_GATE + 1 * MiB;
constexpr size_t WS_SLOTOF = WS_RANK + 1 * MiB;
constexpr size_t WS_BBASE = WS_SLOTOF + 1 * MiB;
constexpr size_t WS_COS = WS_BBASE + 1 * MiB;
constexpr size_t WS_SIN = WS_COS + 1 * MiB;
constexpr size_t WS_TW = WS_SIN + 512 * 1024;
constexpr size_t WS_PU = WS_Y + 128 * MiB;
constexpr size_t WS_Y2 = WS_Y;
constexpr size_t WS_END = WS_SIN + 1 * MiB;
constexpr bool F8L0 = true, F8L1 = true;
constexpr float WSCALE = 32.0f, WINV = 1.0f / 32.0f;
constexpr int CW_BAR = 4096, CW_CNT = 16384;

constexpr int RING_BYTES = 131072;
constexpr int LDSCTL_OFF = 135168;
constexpr int LC_BARST = 0;
constexpr int LC_HIST = 64;
constexpr int LC_PST = 256;
constexpr int LC_NT = 384;
constexpr int LC_PTRS = 512;
constexpr int LC_PRE = 6144;
constexpr int LC_GTOK = 8192;
constexpr int LC_TILEE = 1024;
constexpr int LDS_BYTES = 147456;
static_assert(LDSCTL_OFF + LC_TILEE + NTILE * 4 <= LDS_BYTES, "LDS map");

#define RLX_AGENT __ATOMIC_RELAXED, __HIP_MEMORY_SCOPE_AGENT
DEVI unsigned f2bf(float f) { unsigned u = __builtin_bit_cast(unsigned, f); return (u + 0x7fffu + ((u >> 16) & 1u)) >> 16; }
DEVI unsigned pk2(float lo, float hi) { f32x2 v = {lo, hi}; bf16x2_t b = __builtin_convertvector(v, bf16x2_t); return __builtin_bit_cast(unsigned, b); }
DEVI unsigned pk4f8(float a, float b, float c, float d) { int w = 0; w = __builtin_amdgcn_cvt_pk_fp8_f32(a, b, w, false); w = __builtin_amdgcn_cvt_pk_fp8_f32(c, d, w, true); return (unsigned)w; }
DEVI float bflo(unsigned w) { return __builtin_bit_cast(float, w << 16); }
DEVI float bfhi(unsigned w) { return __builtin_bit_cast(float, w & 0xffff0000u); }
DEVI int opaque_tid();
template <int O> DEVI unsigned xor_u32(unsigned v, bool) {
    if constexpr (O < 32) return (unsigned)__builtin_amdgcn_ds_swizzle((int)v, (O << 10) | 0x1F);
    else return (unsigned)__builtin_amdgcn_ds_bpermute(((opaque_tid() ^ 32) & 63) << 2, (int)v);
}
template <int O> DEVI float xor_f32(float v, bool hi32) { return __builtin_bit_cast(float, xor_u32<O>(__builtin_bit_cast(unsigned, v), hi32)); }
DEVI float sum32(float v) { return v + xor_f32<32>(v, false); }
DEVI float max32(float v) { return fmaxf(v, xor_f32<32>(v, false)); }
DEVI float wave_sum(float v) {
    v += xor_f32<1>(v, false); v += xor_f32<2>(v, false); v += xor_f32<4>(v, false); v += xor_f32<8>(v, false); v += xor_f32<16>(v, false);
    return sum32(v);
}
DEVI int opaque_tid() { int t = threadIdx.x; asm volatile("" : "+v"(t)); return t; }

namespace pg8 {
constexpr int BM = 256, BK = 64, HALF = 128, HTB = HALF * BK * 2, STAGE_BYTES = 8 * HTB;
DEVI int lds_byte(int r, int c) { const int st = (r >> 4) * 2 + (c >> 5), rr = r & 15, cc = c & 31, ob = rr * 64 + cc * 2; return st * 1024 + (ob ^ (((ob >> 9) & 1) << 5)); }
DEVI void stage_rc(int b, int& R, int& C) { const int st = b / 1024, sb = b % 1024, swz = sb ^ (((sb >> 9) & 1) << 5); R = (st >> 1) * 16 + swz / 64; C = (st & 1) * 32 + (swz % 64) / 2; }
DEVI int perm32(int rho) { const int n = rho >> 4, i = rho & 15; return 8 * (i >> 2) + 4 * n + (i & 3); }

struct Unit { const char* a; const char* b; int orow, ocol, aux; };

template <class Epi, class Sched, bool ALIGN_EPI, bool FP8 = false, int ABL = 0  , bool GATHER = false, bool ABLK = false>
DEVI void gemm_phase(LAS unsigned char* lds, const int K, const Sched& S, const Epi& E) {
    const int tid = opaque_tid(), wid = __builtin_amdgcn_readfirstlane(tid >> 6), lane = tid & 63, wr = wid >> 2, wc = wid & 3, fr = lane & 15, fq = lane >> 4;
    const int nt = K / BK;
    constexpr int PM = (int)Epi::PERM;
    unsigned voffA[2], voffB[2], gRC[2];
#pragma unroll
    for (int i = 0; i < 2; ++i) { int R, C; stage_rc(tid * 16 + i * 8192, R, C); const int Rb = PM == 2 ? (64 * (R >> 5) + 16 * ((R >> 2) & 3) + 4 * ((R >> 4) & 1) + (R & 3)) : PM == 1 ? ((R & ~31) + perm32(R & 31)) : R;
        voffA[i] = ABLK ? (unsigned)((R >> 4) * 16384 + ((C * 2) >> 5) * 512 + (R & 15) * 32 + ((C * 2) & 31)) : (unsigned)(R * K + C) * 2u; voffB[i] = (unsigned)(Rb * K + C) * 2u; gRC[i] = ((unsigned)R * 4u) | (((unsigned)C * 2u) << 16); }
    unsigned gvo[2] = {0u, 0u}, gnx[2] = {0u, 0u};
    const size_t kstep = (size_t)(BK * 2);
    const int rot = S.rot() & (nt - 1);
#define PG8_KO(lt) ((size_t)(((lt) + rot) & (nt - 1)) * kstep)
    const size_t kstepA = ABLK ? (size_t)2048 : kstep;
#define PG8_KOA(lt) ((size_t)(((lt) + rot) & (nt - 1)) * kstepA)
    const size_t hstep = (size_t)HALF * K * 2;
    const size_t hstepB = PM == 2 ? (size_t)8 * K * 2 : hstep;
    const unsigned ldsw = (unsigned)wid * 1024u;
    const unsigned ptabb = __builtin_amdgcn_readfirstlane((unsigned)(unsigned long long)lds) + (unsigned)(LDSCTL_OFF + LC_PRE);
    const unsigned gtab = __builtin_amdgcn_readfirstlane((unsigned)(unsigned long long)lds) + (unsigned)(LDSCTL_OFF + LC_GTOK);
    const unsigned ldsb = __builtin_amdgcn_readfirstlane((unsigned)(unsigned long long)lds) + ldsw;
    const int aoff = lds_byte(wr * 64 + fr, fq * 8), boff = lds_byte(wc * 32 + fr, fq * 8);
#define PG8_SA(b, h) (((b) * 2 + (h)) * HTB)
#define PG8_SB(b, h) ((4 + (b) * 2 + (h)) * HTB)
#if PG8_BUILTIN_DMA
#define PG8_STAGE(bufoff, gbase, voff) do { _Pragma("unroll") for (int _i = 0; _i < 2; ++_i) \
        __builtin_amdgcn_global_load_lds((const unsigned*)((const char*)(gbase) + (voff)[_i]), (LAS unsigned*)(lds + (bufoff) + ldsw + _i * 8192), 16, 0, 0); } while (0)
#else
#define PG8_STAGE(bufoff, gbase, voff) do { _Pragma("unroll") for (int _i = 0; _i < 2; ++_i) { unsigned keep_; \
        asm volatile("s_mov_b32 %0, m0\n\ts_mov_b32 m0, %3\n\ts_nop 0\n\tglobal_load_lds_dwordx4 %1, %2\n\ts_mov_b32 m0, %0" : "=&s"(keep_) : "v"((voff)[_i]), "s"((const char*)(gbase)), "s"(ldsb + (unsigned)((bufoff) + _i * 8192)) : "memory"); } } while (0)
#endif
#define PG8_GLOAD(bufi, u_) do { if constexpr (GATHER) { if (wid < 4) { unsigned keep_; \
        asm volatile("s_mov_b32 %0, m0\n\ts_mov_b32 m0, %3\n\ts_nop 0\n\tglobal_load_lds_dword %1, %2\n\ts_mov_b32 m0, %0" : "=&s"(keep_) \
            : "v"((unsigned)((u_).orow * 4) + (unsigned)((opaque_tid() & 255) * 4)), "s"((const char*)S.slot_tok), "s"(gtab + (unsigned)((bufi) * 1024) + (unsigned)(wid * 256)) : "memory"); } } } while (0)
#define PG8_GOFF(dst, h, bufsel) do { if constexpr (GATHER) { _Pragma("unroll") for (int _i = 0; _i < 2; ++_i) { \
        const unsigned tok_ = *(const LAS unsigned*)(lds + LDSCTL_OFF + LC_GTOK + ((bufsel) & 1) * 1024 + (h) * 512 + (gRC[_i] & 0xffffu)); dst[_i] = tok_ * (unsigned)(K * 2) + (gRC[_i] >> 16); } } } while (0)
#define PG8_GNEXT() do { if constexpr (GATHER) { gvo[0] = gnx[0]; gvo[1] = gnx[1]; } } while (0)
#define PG8_STAGE_A(bufoff, base, h) do { if constexpr (GATHER) { PG8_STAGE(bufoff, base, gvo); } else PG8_STAGE(bufoff, (base) + (h) * hstep, voffA); } while (0)
#define PG8_LDA(dst, b, h) do { _Pragma("unroll") for (int m = 0; m < 4; ++m) _Pragma("unroll") for (int k = 0; k < 2; ++k) dst[m][k] = *(const LAS bf16x8*)(lds + PG8_SA(b, h) + aoff + m * 2048 + k * 1024); } while (0)
#define PG8_LDB(dst, b, h) do { _Pragma("unroll") for (int n = 0; n < 2; ++n) _Pragma("unroll") for (int k = 0; k < 2; ++k) dst[n][k] = *(const LAS bf16x8*)(lds + PG8_SB(b, h) + boff + n * 2048 + k * 1024); } while (0)
#define PG8_CAT(x) __builtin_shufflevector(__builtin_bit_cast(i32x4, (x)[0]), __builtin_bit_cast(i32x4, (x)[1]), 0, 1, 2, 3, 4, 5, 6, 7)
#define PG8_MMA(ai, bj, At, Bt) do { if constexpr (ABL == 2) { asm volatile("" :: "v"(At[0][0]), "v"(At[3][1]), "v"(Bt[0][0]), "v"(Bt[1][1])); break; } __builtin_amdgcn_s_setprio(1); _Pragma("unroll") for (int m = 0; m < 4; ++m) _Pragma("unroll") for (int n = 0; n < 2; ++n) { \
        if constexpr (FP8) acc[ai][bj][m][n] = __builtin_amdgcn_mfma_scale_f32_16x16x128_f8f6f4(PG8_CAT(Bt[n]), PG8_CAT(At[m]), acc[ai][bj][m][n], 0, 0, 0, 0, 0, 0); \
        else { _Pragma("unroll") for (int k = 0; k < 2; ++k) acc[ai][bj][m][n] = __builtin_amdgcn_mfma_f32_16x16x32_bf16(Bt[n][k], At[m][k], acc[ai][bj][m][n], 0, 0, 0); } } __builtin_amdgcn_s_setprio(0); } while (0)
#define PG8_WAIT_V(n) asm volatile("s_waitcnt vmcnt(" #n ")" ::: "memory")
#define PG8_WAIT_L(n) asm volatile("s_waitcnt lgkmcnt(" #n ")" ::: "memory")
#define PG8_BAR __builtin_amdgcn_s_barrier()
#define PG8_SCHED __builtin_amdgcn_sched_barrier(0)
    Unit cur, nxt; int ui = 0;
    if (!S.next(0, cur)) return;
    f32x4 acc[2][2][4][2];
#pragma unroll
    for (int a = 0; a < 2; ++a)
#pragma unroll
        for (int b = 0; b < 2; ++b)
#pragma unroll
            for (int m = 0; m < 4; ++m)
#pragma unroll
                for (int n = 0; n < 2; ++n) acc[a][b][m][n] = (f32x4){0.f, 0.f, 0.f, 0.f};
    bf16x8 At[4][2], B0[2][2], B1[2][2];
    const char* cA = cur.a; const char* cB = cur.b;
    if constexpr (GATHER) { PG8_GLOAD(0, cur); asm volatile("s_waitcnt vmcnt(0)" ::: "memory"); __builtin_amdgcn_s_barrier(); asm volatile("" ::: "memory"); }
    PG8_STAGE(PG8_SB(0, 0), cB + PG8_KO(0), voffB); PG8_STAGE(PG8_SB(0, 1), cB + hstepB + PG8_KO(0), voffB); PG8_GOFF(gvo, 0, 0); PG8_STAGE_A(PG8_SA(0, 0), cA + PG8_KOA(0), 0); PG8_GOFF(gvo, 1, 0); PG8_STAGE_A(PG8_SA(0, 1), cA + PG8_KOA(0), 1);
    if (wr == 1) PG8_BAR;
    PG8_WAIT_V(2); PG8_BAR;
    PG8_STAGE(PG8_SB(1, 0), cB + PG8_KO(1), voffB); PG8_GOFF(gvo, 0, 0); PG8_STAGE_A(PG8_SA(1, 0), cA + PG8_KOA(1), 0); PG8_STAGE(PG8_SB(1, 1), cB + hstepB + PG8_KO(1), voffB);
    PG8_WAIT_V(6); PG8_BAR;
    for (;;) {
        const bool has_next = S.next(ui + 1, nxt);
        const char* nA = has_next ? nxt.a : cA; const char* nB = has_next ? nxt.b : cB;
        if (has_next) PG8_GLOAD((ui + 1) & 1, nxt);
        PG8_GOFF(gnx, 1, ui);
        if constexpr (Epi::PRE) { if (wid < 4) { unsigned keep_;
            asm volatile("s_mov_b32 %0, m0\n\ts_mov_b32 m0, %3\n\ts_nop 0\n\tglobal_load_lds_dword %1, %2\n\ts_mov_b32 m0, %0" : "=&s"(keep_)
                : "v"(E.pre_off(cur, (opaque_tid() & 255))), "s"(E.pre_base()), "s"(ptabb + (unsigned)((ui & 1) * 1024) + (unsigned)(wid * 256)) : "memory"); } }
#pragma unroll 1
        for (int t = 0; t < nt; t += 2) {
            const bool last = (t == nt - 2);
            const char* a1 = cA + PG8_KOA(t + 1);
            const size_t ko2 = PG8_KO(last ? 0 : t + 2), ko3 = PG8_KO(last ? 1 : t + 3);
            const char* a2 = (last ? nA : cA) + (ABLK ? PG8_KOA(last ? 0 : t + 2) : ko2); const char* b2 = (last ? nB : cB) + ko2;
            const char* a3 = (last ? nA : cA) + (ABLK ? PG8_KOA(last ? 1 : t + 3) : ko3); const char* b3 = (last ? nB : cB) + ko3;
            const int nb_ = (last && has_next) ? ui + 1 : ui;
            PG8_GNEXT(); PG8_LDB(B0, 0, 0); PG8_LDB(B1, 0, 1); PG8_SCHED; PG8_LDA(At, 0, 0); PG8_GOFF(gnx, 0, nb_); PG8_STAGE_A(PG8_SA(1, 1), a1, 1);
            PG8_WAIT_V(8); PG8_WAIT_L(0); PG8_BAR; PG8_MMA(0, 0, At, B0); PG8_MMA(0, 1, At, B1); PG8_BAR; PG8_SCHED;
            PG8_GNEXT(); PG8_LDA(At, 0, 1); PG8_GOFF(gnx, 1, nb_); PG8_STAGE(PG8_SB(0, 0), b2, voffB); PG8_STAGE(PG8_SB(0, 1), b2 + hstepB, voffB); PG8_STAGE_A(PG8_SA(0, 0), a2, 0);
            PG8_WAIT_V(8); PG8_WAIT_L(0); PG8_BAR; PG8_MMA(1, 0, At, B0); PG8_MMA(1, 1, At, B1); PG8_BAR; PG8_SCHED;
            PG8_GNEXT(); PG8_LDB(B0, 1, 0); PG8_LDB(B1, 1, 1); PG8_SCHED; PG8_LDA(At, 1, 0); PG8_GOFF(gnx, 0, nb_); PG8_STAGE_A(PG8_SA(0, 1), a2, 1);
            PG8_WAIT_V(8); PG8_WAIT_L(0); PG8_BAR; PG8_MMA(0, 0, At, B0); PG8_MMA(0, 1, At, B1); PG8_BAR; PG8_SCHED;
            PG8_GNEXT(); PG8_LDA(At, 1, 1); if (!last) PG8_GOFF(gnx, 1, nb_); PG8_STAGE(PG8_SB(1, 0), b3, voffB); PG8_STAGE(PG8_SB(1, 1), b3 + hstepB, voffB); PG8_STAGE_A(PG8_SA(1, 0), a3, 0);
            PG8_WAIT_V(8); PG8_WAIT_L(0); PG8_BAR; PG8_MMA(1, 0, At, B0); PG8_MMA(1, 1, At, B1); PG8_BAR; PG8_SCHED;
        }
        if constexpr (ALIGN_EPI) { if (wr == 0) PG8_BAR; }
        if constexpr (ABL == 0) E(acc, cur, (const LAS float*)(lds + LDSCTL_OFF + LC_PRE + (ui & 1) * 1024)); else { _Pragma("unroll") for (int a_ = 0; a_ < 2; ++a_) _Pragma("unroll") for (int b_ = 0; b_ < 2; ++b_) _Pragma("unroll") for (int m_ = 0; m_ < 4; ++m_) _Pragma("unroll") for (int n_ = 0; n_ < 2; ++n_) asm volatile("" :: "v"(acc[a_][b_][m_][n_])); }
        if (!has_next) break;
#pragma unroll
        for (int a = 0; a < 2; ++a)
#pragma unroll
            for (int b = 0; b < 2; ++b)
#pragma unroll
                for (int m = 0; m < 4; ++m)
#pragma unroll
                    for (int n = 0; n < 2; ++n) acc[a][b][m][n] = (f32x4){0.f, 0.f, 0.f, 0.f};
        cur = nxt; cA = nA; cB = nB; ++ui;
        if constexpr (ALIGN_EPI) { if (wr == 1) PG8_BAR; }
    }
    PG8_WAIT_V(0);
    if constexpr (!ALIGN_EPI) { if (wr == 0) PG8_BAR; }
    PG8_BAR;
#undef PG8_KO
#undef PG8_KOA
#undef PG8_SA
#undef PG8_SB
#undef PG8_STAGE
#undef PG8_STAGE_A
#undef PG8_GLOAD
#undef PG8_GOFF
#undef PG8_GNEXT
#undef PG8_LDA
#undef PG8_LDB
#undef PG8_MMA
#undef PG8_CAT
#undef PG8_WAIT_V
#undef PG8_WAIT_L
#undef PG8_BAR
#undef PG8_SCHED
}
}
using pg8::Unit;
typedef f32x4 Acc[2][2][4][2];

template <int BIAS  , int LDC, bool S32 = false  , bool O8 = false  >
struct EpiBf16 {
    static constexpr int PERM = O8 ? 2 : 1;
    static constexpr bool PRE = (BIAS == 1);
    DEVI const char* pre_base() const { return (const char*)bias; }
    DEVI unsigned pre_off(const Unit& u, int f) const { const int q = f >> 4, i = f & 15; return (unsigned)(u.aux + (O8 ? (q >> 2) * 64 + (q & 3) * 16 + i : (q >> 2) * 32 + (q & 3) * 8 + (i & 7) + 128 * (i >> 3))) * 4u; }
    bf16_t* O; const float* bias;
    DEVI void operator()(const Acc& acc, const Unit& u, const LAS float* ptab) const {
        const int tid_ = opaque_tid(), wid_ = tid_ >> 6, wr = wid_ >> 2, wc = wid_ & 3, fr = tid_ & 15, fq = (tid_ & 63) >> 4;
        const int lc = wc * 32 + 8 * fq;
        bf16_t* base = O + (size_t)(u.orow + wr * 64 + fr) * LDC + u.ocol + lc;
        const float* bp = bias + u.aux + (BIAS == 1 ? lc : wr * 64 + fr);
        f32x4 bc[2][2];
        if (BIAS == 1) { const LAS f32x4* tb = (const LAS f32x4*)(ptab + (wc * 4 + fq) * 16); bc[0][0] = tb[0]; bc[0][1] = tb[1]; bc[1][0] = tb[2]; bc[1][1] = tb[3]; }
#pragma unroll
        for (int ai = 0; ai < 2; ++ai)
#pragma unroll
            for (int m = 0; m < 4; ++m) {
                bf16_t* rowp = base + (size_t)(ai * 128 + m * 16) * LDC;
                float br = 0.f; if (BIAS == 2) br = bp[ai * 128 + m * 16];
                u32x4 w8;
#pragma unroll
                for (int bj = 0; bj < 2; ++bj) {
                    f32x4 v0 = acc[ai][bj][m][0], v1 = acc[ai][bj][m][1];
                    if (S32) { v0 *= WINV; v1 *= WINV; }
                    if (BIAS == 1) { v0 += bc[bj][0]; v1 += bc[bj][1]; }
                    if (BIAS == 2) { v0 += br; v1 += br; }
                    if (O8) { w8[2 * bj] = pk4f8(v0[0], v0[1], v0[2], v0[3]); w8[2 * bj + 1] = pk4f8(v1[0], v1[1], v1[2], v1[3]); }
                    else { u32x4 w; w.x = pk2(v0[0], v0[1]); w.y = pk2(v0[2], v0[3]); w.z = pk2(v1[0], v1[1]); w.w = pk2(v1[2], v1[3]);
                    *(u32x4*)(rowp + bj * 128) = w; }
                }
                if (O8) *(u32x4*)((unsigned char*)O + ((size_t)(u.orow + wr * 64 + fr + ai * 128 + m * 16) * LDC + u.ocol + wc * 64 + 16 * fq)) = w8;
                asm volatile("" ::: "memory");
            }
    }
};
struct EpiX {
    static constexpr bool PERM = true;
    static constexpr bool PRE = false;
    const bf16_t* R; bf16_t* X; const float* bias;
    DEVI void operator()(const Acc& acc, const Unit& u, const LAS float* ptab) const {
        const int tid_ = opaque_tid(), wid_ = tid_ >> 6, wr = wid_ >> 2, wc = wid_ & 3, fr = tid_ & 15, fq = (tid_ & 63) >> 4;
        const int col0 = u.ocol + wc * 32 + 8 * fq;
        f32x4 bv[2][2];
#pragma unroll
        for (int bj = 0; bj < 2; ++bj)
#pragma unroll
            for (int n = 0; n < 2; ++n) bv[bj][n] = *(const f32x4*)(bias + col0 + bj * 128 + n * 4);
        const size_t off0 = (size_t)(u.orow + wr * 64 + fr) * D + col0;
        u32x4 rc[2], rn[2];
#pragma unroll
        for (int bj = 0; bj < 2; ++bj) rc[bj] = *(const u32x4*)(R + off0 + bj * 128);
#pragma unroll
        for (int it = 0; it < 8; ++it) {
            const int ai = it >> 2, m = it & 3;
            const size_t off = off0 + (size_t)(ai * 128 + m * 16) * D;
            if (it < 7) { const size_t offn = off0 + (size_t)(((it + 1) >> 2) * 128 + ((it + 1) & 3) * 16) * D;
#pragma unroll
                for (int bj = 0; bj < 2; ++bj) rn[bj] = *(const u32x4*)(R + offn + bj * 128); }
#pragma unroll
            for (int bj = 0; bj < 2; ++bj) {
                const u32x4 rw = rc[bj];
                const f32x4 v0 = (f32x4){bflo(rw.x), bfhi(rw.x), bflo(rw.y), bfhi(rw.y)} + acc[ai][bj][m][0] + bv[bj][0], v1 = (f32x4){bflo(rw.z), bfhi(rw.z), bflo(rw.w), bfhi(rw.w)} + acc[ai][bj][m][1] + bv[bj][1];
                u32x4 w; w.x = pk2(v0[0], v0[1]); w.y = pk2(v0[2], v0[3]); w.z = pk2(v1[0], v1[1]); w.w = pk2(v1[2], v1[3]);
                *(u32x4*)(X + off + bj * 128) = w;
            }
#pragma unroll
            for (int bj = 0; bj < 2; ++bj) rc[bj] = rn[bj];
            asm volatile("" ::: "memory");
        }
    }
};
struct EpiF32 {
    static constexpr bool PERM = true;
    static constexpr bool PRE = false;
    bf16_t* C;
    DEVI void operator()(const Acc& acc, const Unit& u, const LAS float* ptab) const {
        const int tid_ = opaque_tid(), wid_ = tid_ >> 6, wr = wid_ >> 2, wc = wid_ & 3, fr = tid_ & 15, fq = (tid_ & 63) >> 4;
        bf16_t* base = C + (size_t)(u.orow + wr * 64 + fr) * D + u.ocol + wc * 32 + 8 * fq;
#pragma unroll
        for (int ai = 0; ai < 2; ++ai)
#pragma unroll
            for (int m = 0; m < 4; ++m)
#pragma unroll
                for (int bj = 0; bj < 2; ++bj) { const f32x4 v0 = acc[ai][bj][m][0], v1 = acc[ai][bj][m][1];
                    u32x4 w; w.x = pk2(v0[0], v0[1]); w.y = pk2(v0[2], v0[3]); w.z = pk2(v1[0], v1[1]); w.w = pk2(v1[2], v1[3]);
                    *(u32x4*)(base + (size_t)(ai * 128 + m * 16) * D + bj * 128) = w; }
    }
};
struct EpiMirror {
    static constexpr bool PERM = true;
    static constexpr bool PRE = false;
    const float* R; bf16_t* X; const float* bias; const bf16_t* PU;
    DEVI void operator()(const Acc& acc, const Unit& u, const LAS float* ptab) const {
        const int tid_ = opaque_tid(), wid_ = tid_ >> 6, wr = wid_ >> 2, wc = wid_ & 3, fr = tid_ & 15, fq = (tid_ & 63) >> 4;
        const int col0 = u.ocol + wc * 32 + 8 * fq;
        const int r0 = u.orow + wr * 64 + fr;
        const int bat = r0 >> 11, sp0 = r0 & 2047;
        const float* x1p = R + ((size_t)bat * SEQ + sp0) * D + col0; bf16_t* y1p = X + ((size_t)bat * SEQ + sp0) * D + col0;
        const bf16_t* pup = PU + (size_t)r0 * D + col0;
        f32x4 bv[2][2];
#pragma unroll
        for (int bj = 0; bj < 2; ++bj)
#pragma unroll
            for (int n = 0; n < 2; ++n) bv[bj][n] = *(const f32x4*)(bias + col0 + bj * 128 + n * 4);
        u32x4 pc, pn; f32x4 ac[2], bc2[2], an[2], bn[2];
#define EM_LOAD(P_, A_, B_, st_) { const int ro_ = ((st_) >> 3) * 128 + (((st_) >> 1) & 3) * 16, co_ = ((st_) & 1) * 128, spn_ = sp0 + ro_; \
        const float* x2p_ = R + ((size_t)bat * SEQ + ((SEQ - spn_) & (SEQ - 1))) * D + col0 + co_; \
        P_ = __builtin_nontemporal_load((const u32x4*)(pup + (size_t)ro_ * D + co_)); \
        _Pragma("unroll") for (int n = 0; n < 2; ++n) { A_[n] = *(const f32x4*)(x1p + (size_t)ro_ * D + co_ + n * 4); B_[n] = *(const f32x4*)(x2p_ + n * 4); } }
        EM_LOAD(pc, ac, bc2, 0)
#pragma unroll
        for (int st = 0; st < 16; ++st) {
            const int ai = st >> 3, m = (st >> 1) & 3, bj = st & 1, ro = ai * 128 + m * 16, co = bj * 128, sp = sp0 + ro;
            if (st < 15) EM_LOAD(pn, an, bn, st + 1)
            bf16_t* x2o = X + ((size_t)bat * SEQ + ((SEQ - sp) & (SEQ - 1))) * D + col0 + co;
            const f32x4 pu0 = (f32x4){bflo(pc.x), bfhi(pc.x), bflo(pc.y), bfhi(pc.y)} + bv[bj][0], pu1 = (f32x4){bflo(pc.z), bfhi(pc.z), bflo(pc.w), bfhi(pc.w)} + bv[bj][1];
            { const f32x4 o0 = ac[0] + pu0 + acc[ai][bj][m][0], o1 = ac[1] + pu1 + acc[ai][bj][m][1];
              u32x4 w; w.x = pk2(o0[0], o0[1]); w.y = pk2(o0[2], o0[3]); w.z = pk2(o1[0], o1[1]); w.w = pk2(o1[2], o1[3]); *(u32x4*)(y1p + (size_t)ro * D + co) = w; }
            if (sp != 0) { const f32x4 o0 = bc2[0] + pu0 - acc[ai][bj][m][0], o1 = bc2[1] + pu1 - acc[ai][bj][m][1];
              u32x4 w; w.x = pk2(o0[0], o0[1]); w.y = pk2(o0[2], o0[3]); w.z = pk2(o1[0], o1[1]); w.w = pk2(o1[2], o1[3]); *(u32x4*)x2o = w; }
            pc = pn;
#pragma unroll
            for (int n = 0; n < 2; ++n) { ac[n] = an[n]; bc2[n] = bn[n]; }
            asm volatile("" ::: "memory");
        }
#undef EM_LOAD
    }
};
template <bool F8>
struct EpiGLU {
    static constexpr bool PERM = true;
    static constexpr bool PRE = true;
    DEVI const char* pre_base() const { return (const char*)bgu; }
    DEVI unsigned pre_off(const Unit& u, int f) const { const int q = f >> 4, i = f & 15; return (unsigned)(u.aux * 2048 + u.ocol + (q >> 2) * 32 + (q & 3) * 8 + (i & 7) + 1024 * (i >> 3)) * 4u; }
    unsigned char* HID; const float* bgu;
    DEVI void operator()(const Acc& acc, const Unit& u, const LAS float* ptab) const {
        const int tid_ = opaque_tid(), wid_ = tid_ >> 6, wr = wid_ >> 2, wc = wid_ & 3, fr = tid_ & 15, fq = (tid_ & 63) >> 4;
        const int lc = wc * 32 + 8 * fq;
        const LAS f32x4* tb = (const LAS f32x4*)(ptab + (wc * 4 + fq) * 16);
        const f32x4 g0 = tb[0], g1 = tb[1], u0 = tb[2], u1 = tb[3];
        constexpr int EB = F8 ? 1 : 2; constexpr float SC = F8 ? WINV : 1.0f;
        unsigned char* base = F8 ? HID + ((size_t)((u.orow >> 4) + wr * 4) * 8 + (u.ocol >> 7)) * 2048 + wc * 512 + fr * 32 + 8 * fq : HID + ((size_t)(u.orow + wr * 64 + fr) * D + u.ocol + lc) * EB;
#pragma unroll
        for (int ai = 0; ai < 2; ++ai)
#pragma unroll
            for (int m = 0; m < 4; ++m) {
                float o[8];
#pragma unroll
                for (int n = 0; n < 2; ++n)
#pragma unroll
                    for (int j = 0; j < 4; j += 2) {
                        const f32x4 bgv = n ? g1 : g0, buv = n ? u1 : u0;
                        f32x2 g = (f32x2){acc[ai][0][m][n][j], acc[ai][0][m][n][j + 1]} * SC + (f32x2){bgv[j], bgv[j + 1]};
                        f32x2 up = (f32x2){acc[ai][1][m][n][j], acc[ai][1][m][n][j + 1]} * SC + (f32x2){buv[j], buv[j + 1]};
                        g.x = fminf(g.x, 7.0f); g.y = fminf(g.y, 7.0f);
                        up.x = __builtin_amdgcn_fmed3f(up.x, -7.0f, 7.0f); up.y = __builtin_amdgcn_fmed3f(up.y, -7.0f, 7.0f);
                        f32x2 e = g * (-1.702f * 1.4426950408889634f);
                        e.x = __builtin_amdgcn_exp2f(e.x); e.y = __builtin_amdgcn_exp2f(e.y);
                        const f32x2 d = e + 1.0f;
                        f32x2 r; r.x = __builtin_amdgcn_rcpf(d.x); r.y = __builtin_amdgcn_rcpf(d.y);
                        const f32x2 glu = g * r, ov = up * glu + glu;
                        o[n * 4 + j] = ov.x; o[n * 4 + j + 1] = ov.y;
                    }
                unsigned char* dp = F8 ? base + (size_t)(ai * 8 + m) * 16384 : base + (size_t)(ai * 128 + m * 16) * D * EB;
                if (F8) { u32x2 w; w.x = pk4f8(o[0], o[1], o[2], o[3]); w.y = pk4f8(o[4], o[5], o[6], o[7]); *(u32x2*)dp = w; }
                else { u32x4 w; w.x = pk2(o[0], o[1]); w.y = pk2(o[2], o[3]); w.z = pk2(o[4], o[5]); w.w = pk2(o[6], o[7]); *(u32x4*)dp = w; }
                asm volatile("" ::: "memory");
            }
    }
};
struct EpiQK {
    static constexpr bool PERM = true;
    static constexpr bool PRE = false;
    bf16_t* Q; bf16_t* Kb; const float* bias; const float* cosT;
    DEVI void operator()(const Acc& acc, const Unit& u, const LAS float* ptab) const {
        const int tid_ = opaque_tid(), wid_ = tid_ >> 6, wr = wid_ >> 2, wc = wid_ & 3, fr = tid_ & 15, fq = (tid_ & 63) >> 4;
        const int pn = u.aux; const bool isq = pn < 4;
        bf16_t* base = isq ? Q + pn * 256 : Kb; const long ld = isq ? 1024 : 256; const float sc = isq ? 0.125f * 1.4426950408889634f : 1.0f;
        const int i0 = 8 * fq;
        const float* bp = bias + pn * 256 + wc * 64 + i0;
        bf16_t* rbase = base + (size_t)(u.orow + wr * 64 + fr) * ld + wc * 64 + i0;
        const int pos0 = (u.orow + wr * 64 + fr) & (SEQ - 1);
        const f32x4 bl0 = *(const f32x4*)bp, bl1 = *(const f32x4*)(bp + 4), bh0 = *(const f32x4*)(bp + 32), bh1 = *(const f32x4*)(bp + 36);
        const float* tp = cosT + pos0 * 32 + i0;
        f32x4 c0 = *(const f32x4*)tp, c1 = *(const f32x4*)(tp + 4), s0 = *(const f32x4*)(tp + 262144), s1 = *(const f32x4*)(tp + 262144 + 4), nc0, nc1, ns0, ns1;
#pragma unroll
        for (int it = 0; it < 8; ++it) {
            const int ai = it >> 2, m = it & 3;
            if (it < 7) { const float* tn = tp + (((it + 1) >> 2) * 128 + ((it + 1) & 3) * 16) * 32;
                nc0 = *(const f32x4*)tn; nc1 = *(const f32x4*)(tn + 4); ns0 = *(const f32x4*)(tn + 262144); ns1 = *(const f32x4*)(tn + 262144 + 4); }
            const f32x4 lo0 = acc[ai][0][m][0] + bl0, lo1 = acc[ai][0][m][1] + bl1, hi0 = acc[ai][1][m][0] + bh0, hi1 = acc[ai][1][m][1] + bh1;
            const f32x4 ol0 = (lo0 * c0 - hi0 * s0) * sc, ol1 = (lo1 * c1 - hi1 * s1) * sc;
            const f32x4 oh0 = (hi0 * c0 + lo0 * s0) * sc, oh1 = (hi1 * c1 + lo1 * s1) * sc;
            bf16_t* rowp = rbase + (size_t)(ai * 128 + m * 16) * ld;
            u32x4 w; w.x = pk2(ol0[0], ol0[1]); w.y = pk2(ol0[2], ol0[3]); w.z = pk2(ol1[0], ol1[1]); w.w = pk2(ol1[2], ol1[3]);
            *(u32x4*)rowp = w;
            w.x = pk2(oh0[0], oh0[1]); w.y = pk2(oh0[2], oh0[3]); w.z = pk2(oh1[0], oh1[1]); w.w = pk2(oh1[2], oh1[3]);
            *(u32x4*)(rowp + 32) = w;
            c0 = nc0; c1 = nc1; s0 = ns0; s1 = ns1;
            asm volatile("" ::: "memory");
        }
    }
};

struct SchedDFT {
    const char* CS; const char* HT; int G, v;
    DEVI bool next(int i, Unit& u) const {
        const int L = i * G + v; if (L >= 1024) return false;
        const int b = L >> 7, j = L & 127, pm = (j >> 5) * 8 + (j & 7), pn = (j >> 3) & 3;
        u.a = CS + (size_t)pm * 256 * SEQ * 2; u.b = HT + ((size_t)b * D + pn * 256) * SEQ * 2;
        u.orow = b * SEQ + (pm & 15) * 256; u.ocol = (pm >> 4) * 1024 + pn * 256; u.aux = 0; return true;
    }
};
template <int NPN>
struct SchedRows {
    const char* A; const char* Bt; int K, nunits, G, v;
    DEVI int rot() const { return 0; }
    DEVI bool next(int i, Unit& u) const {
        const int L = i * G + v; if (L >= nunits) return false;
        const int grp = L / (8 * NPN), j = L % (8 * NPN), pm = grp * 8 + (j & 7), pn = j >> 3;
        u.a = A + (size_t)pm * 256 * K * 2; u.b = Bt + (size_t)pn * 256 * K * 2;
        u.orow = pm * 256; u.ocol = pn * 256; u.aux = pn; return true;
    }
};
struct SchedVT {
    const char* Wv; const char* HN; int G, v, v0;
    DEVI int rot() const { return 0; }
    DEVI bool next(int i, Unit& u) const {
        const int L = i * G + v - v0; if (L < 0 || L >= T / 256) return false;
        u.a = Wv; u.b = HN + (size_t)L * 256 * D * 2; u.orow = 0; u.ocol = L * 256; u.aux = 1280; return true;
    }
};
template <int NPN> DEVI bool moe_unit(int i, int G, int v, int ntiles, int& tr, int& pn) {
    if ((G & 7) == 0) {
        const int P = G >> 3, x = v / P, j = v - x * P, r0 = (x * ntiles) >> 3, r1 = ((x + 1) * ntiles) >> 3, q = i * P + j;
        tr = r0 + q / NPN; pn = q % NPN; return tr < r1;
    }
    const int L = i * G + v; tr = L / NPN; pn = L % NPN; return L < ntiles * NPN;
}
template <int NPN> DEVI int moe_rot(int G, int v) {
    if ((G & 7) != 0) return 0;
    const int P = G >> 3, j = v % P, pn = j % NPN, tl = j / NPN;
    return NPN == 8 ? (pn + 2 * tl) & 7 : (2 * pn + tl) & 7;
}
template <int NPN, int WROWS, int OCW, bool AUXB, int RB  >
struct SchedMoE {
    const char* A; const char* W; const LAS int* tile_e; int ntiles, G, v;
    DEVI int rot() const { return moe_rot<NPN>(G, v); }
    DEVI bool next(int i, Unit& u) const {
        int tr, pn; if (!moe_unit<NPN>(i, G, v, ntiles, tr, pn)) return false;
        const int e = __builtin_amdgcn_readfirstlane(tile_e[tr]);
        u.a = A + (size_t)tr * 256 * RB; u.b = W + ((size_t)e * WROWS + pn * 256) * RB;
        u.orow = tr * 256; u.ocol = pn * OCW; u.aux = AUXB ? e * D + pn * OCW : e; return true;
    }
};

template <int NPN, int WROWS, int OCW, int RB>
struct SchedMoEG {
    const char* A; const char* W; const LAS int* tile_e; const int* slot_tok; int ntiles, G, v;
    DEVI int rot() const { return moe_rot<NPN>(G, v); }
    DEVI bool next(int i, Unit& u) const {
        int tr, pn; if (!moe_unit<NPN>(i, G, v, ntiles, tr, pn)) return false;
        const int e = __builtin_amdgcn_readfirstlane(tile_e[tr]);
        u.a = A; u.b = W + ((size_t)e * WROWS + pn * 256) * RB;
        u.orow = tr * 256; u.ocol = pn * OCW; u.aux = e; return true;
    }
};

#define XB_TMO      128
#define XB_XCNT(j)  (256  + 64 * (j))
#define XB_XSUB(j)  (1280 + 64 * (j))
#define XB_XGEN(j)  (2304 + 64 * (j))
#define XB_TOP      3328
#define XB_TOPGEN   3392
#define XCD_BAR_WORDS 3456
#define XB_SPIN_CAP (1u << 20)
DEVI unsigned xb_ld(unsigned* p)              { return __hip_atomic_load(p, RLX_AGENT); }
DEVI unsigned xb_add(unsigned* p, unsigned v) { return __hip_atomic_fetch_add(p, v, RLX_AGENT); }
DEVI unsigned xb_xcc_id() { return (unsigned)__builtin_amdgcn_s_getreg((3 << 11) | 20) & 0xFu; }
#define XB_SPIN(cond, bar) do { unsigned _sp = 0; while (cond) { __builtin_amdgcn_s_sleep(1); \
    if ((++_sp & 255u) == 0u) { if (xb_ld(&(bar)[XB_TMO])) break; if (_sp > XB_SPIN_CAP) { atomicAdd(&(bar)[XB_TMO], 1u); break; } } } } while (0)
struct XcdBarrier { unsigned* bar; unsigned x; volatile LAS unsigned* st; };
DEVI XcdBarrier xcd_barrier_post(unsigned* bar, volatile LAS unsigned* st) {
    XcdBarrier b; b.bar = bar; b.x = xb_xcc_id(); b.st = st;
    if (threadIdx.x == 0) (void)xb_add(&bar[XB_XCNT(b.x)], 1u);
    return b;
}
DEVI void xcd_barrier_complete(unsigned* bar, unsigned x, unsigned& nloc, unsigned& nx) {
    const unsigned G = gridDim.x * gridDim.y * gridDim.z;
    unsigned sum, cnt, mine, sp = 0u;
    for (;;) {
        sum = 0u; cnt = 0u; mine = 0u;
#pragma unroll
        for (unsigned j = 0; j < 16; ++j) { const unsigned c = xb_ld(&bar[XB_XCNT(j)]); sum += c; cnt += (c > 0u) ? 1u : 0u; mine = (j == x) ? c : mine; }
        if (sum == G) break;
        __builtin_amdgcn_s_sleep(1);
        if ((++sp & 255u) == 0u) { if (xb_ld(&bar[XB_TMO])) break; if (sp > XB_SPIN_CAP) { atomicAdd(&bar[XB_TMO], 1u); break; } }
    }
    nloc = mine > 0u ? mine : 1u; nx = cnt > 0u ? cnt : 1u;
}
DEVI void xcd_barrier(const XcdBarrier& b) {
    asm volatile("s_waitcnt vmcnt(0)" ::: "memory");
    __syncthreads();
    if (threadIdx.x == 0) {
        unsigned* bar = b.bar; asm volatile("" : "+s"(bar));
        __builtin_amdgcn_s_waitcnt(0);
        unsigned nloc = b.st[0], nx = b.st[1];
        if (nloc == 0u) { xcd_barrier_complete(bar, b.x, nloc, nx); b.st[0] = nloc; b.st[1] = nx; }
        const unsigned old = xb_add(&bar[XB_XSUB(b.x)], 1u);
        const unsigned gen = old / nloc;
        if (old + 1u == (gen + 1u) * nloc) {
            __builtin_amdgcn_fence(__ATOMIC_RELEASE, "agent");
            asm volatile("s_waitcnt vmcnt(0)" ::: "memory");
            const unsigned og = xb_add(&bar[XB_TOP], 1u);
            const unsigned tg = og / nx;
            if (og + 1u == (tg + 1u) * nx) xb_add(&bar[XB_TOPGEN], 1u);
            else XB_SPIN(xb_ld(&bar[XB_TOPGEN]) == tg, bar);
            __builtin_amdgcn_fence(__ATOMIC_ACQUIRE, "agent");
            xb_add(&bar[XB_XGEN(b.x)], 1u);
            asm volatile("s_waitcnt vmcnt(0)" ::: "memory");
        } else {
            XB_SPIN(xb_ld(&bar[XB_XGEN(b.x)]) == gen, bar);
            __builtin_amdgcn_fence(__ATOMIC_ACQUIRE, "agent");
            asm volatile("s_waitcnt vmcnt(0)" ::: "memory");
        }
    }
    __syncthreads();
}

struct Ctx { LAS unsigned char* lds; int tid, lane, wave, v, G; };
DEVI Ctx refresh(const Ctx& c0) { Ctx c = c0; c.tid = opaque_tid(); c.lane = c.tid & 63; return c; }

DEVI void transpose_item64_f8(const float* W, int ldw, int k0, int ca, int cb, unsigned char* dst, int K, int rho0, LAS float* scr, int lane) {
    const int r = lane >> 4, q = lane & 15, cs = (q < 8) ? ca + 4 * q : cb + 4 * (q - 8);
    const float* src = W + (size_t)(k0 + r) * ldw + cs;
    f32x4 v[16];
#pragma unroll
    for (int i = 0; i < 16; ++i) v[i] = *(const f32x4*)(src + (size_t)(4 * i) * ldw);
#pragma unroll
    for (int i = 0; i < 16; ++i) { LAS float* t = scr + (4 * i + r) * 65 + 4 * q; t[0] = v[i].x * WSCALE; t[1] = v[i].y * WSCALE; t[2] = v[i].z * WSCALE; t[3] = v[i].w * WSCALE; }
    asm volatile("s_waitcnt lgkmcnt(0)" ::: "memory");
    const int kc = lane & 3, nn = lane >> 2;
#pragma unroll
    for (int j = 0; j < 4; ++j) { const int n = nn + 16 * j; const LAS float* t = scr + (16 * kc) * 65 + n;
        u32x4 o; o.x = pk4f8(t[0 * 65], t[1 * 65], t[2 * 65], t[3 * 65]); o.y = pk4f8(t[4 * 65], t[5 * 65], t[6 * 65], t[7 * 65]);
        o.z = pk4f8(t[8 * 65], t[9 * 65], t[10 * 65], t[11 * 65]); o.w = pk4f8(t[12 * 65], t[13 * 65], t[14 * 65], t[15 * 65]);
        *(u32x4*)(dst + (size_t)(rho0 + n) * K + k0 + 16 * kc) = o; }
    asm volatile("s_waitcnt lgkmcnt(0)" ::: "memory");
}
DEVI void transpose_item64(const float* W, int ldw, int k0, int ca, int cb, bf16_t* dst, int K, int rho0, LAS float* scr, int lane) {
    const int r = lane >> 4, q = lane & 15, cs = (q < 8) ? ca + 4 * q : cb + 4 * (q - 8);
    const float* src = W + (size_t)(k0 + r) * ldw + cs;
    f32x4 v[16];
#pragma unroll
    for (int i = 0; i < 16; ++i) v[i] = *(const f32x4*)(src + (size_t)(4 * i) * ldw);
#pragma unroll
    for (int i = 0; i < 16; ++i) { LAS float* t = scr + (4 * i + r) * 65 + 4 * q; t[0] = v[i].x; t[1] = v[i].y; t[2] = v[i].z; t[3] = v[i].w; }
    asm volatile("s_waitcnt lgkmcnt(0)" ::: "memory");
    const int kc = lane & 7, nn = lane >> 3;
#pragma unroll
    for (int j = 0; j < 8; ++j) { const int n = nn + 8 * j; const LAS float* t = scr + (8 * kc) * 65 + n;
        u32x4 o; o.x = pk2(t[0 * 65], t[1 * 65]); o.y = pk2(t[2 * 65], t[3 * 65]); o.z = pk2(t[4 * 65], t[5 * 65]); o.w = pk2(t[6 * 65], t[7 * 65]);
        *(u32x4*)(dst + (size_t)(rho0 + n) * K + k0 + 8 * kc) = o; }
    asm volatile("s_waitcnt lgkmcnt(0)" ::: "memory");
}

struct TrItem { const float* src; size_t ldw4; unsigned char* dst; int k0, rho0; bool f8; };
DEVI void tr_load(const TrItem& t, f32x4 (&v)[16]) {
#pragma unroll
    for (int i = 0; i < 16; ++i) v[i] = __builtin_nontemporal_load((const f32x4*)(t.src + (size_t)i * t.ldw4));
}
DEVI void tr_finish(const TrItem& t, const f32x4 (&v)[16], LAS float* scr, int lane) {
    if (t.f8) {
        const int r = lane >> 3, q = lane & 7;
#pragma unroll
        for (int i = 0; i < 16; ++i) { LAS float* p = scr + (8 * i + r) * 33 + 4 * q; p[0] = v[i].x * WSCALE; p[1] = v[i].y * WSCALE; p[2] = v[i].z * WSCALE; p[3] = v[i].w * WSCALE; }
        asm volatile("s_waitcnt lgkmcnt(0)" ::: "memory");
        const int kc = lane & 7, nn = lane >> 3;
#pragma unroll
        for (int j = 0; j < 4; ++j) { const int n = nn + 8 * j; const LAS float* p = scr + (16 * kc) * 33 + n;
            u32x4 o; o.x = pk4f8(p[0 * 33], p[1 * 33], p[2 * 33], p[3 * 33]); o.y = pk4f8(p[4 * 33], p[5 * 33], p[6 * 33], p[7 * 33]);
            o.z = pk4f8(p[8 * 33], p[9 * 33], p[10 * 33], p[11 * 33]); o.w = pk4f8(p[12 * 33], p[13 * 33], p[14 * 33], p[15 * 33]);
            *(u32x4*)(t.dst + (size_t)(t.rho0 + n) * D + t.k0 + 16 * kc) = o; }
    } else {
        const int r = lane >> 4, q = lane & 15;
#pragma unroll
        for (int i = 0; i < 16; ++i) { LAS float* p = scr + (4 * i + r) * 65 + 4 * q; p[0] = v[i].x; p[1] = v[i].y; p[2] = v[i].z; p[3] = v[i].w; }
        asm volatile("s_waitcnt lgkmcnt(0)" ::: "memory");
        const int kc = lane & 7, nn = lane >> 3;
#pragma unroll
        for (int j = 0; j < 8; ++j) { const int n = nn + 8 * j; const LAS float* p = scr + (8 * kc) * 65 + n;
            u32x4 o; o.x = pk2(p[0 * 65], p[1 * 65]); o.y = pk2(p[2 * 65], p[3 * 65]); o.z = pk2(p[4 * 65], p[5 * 65]); o.w = pk2(p[6 * 65], p[7 * 65]);
            *(u32x4*)((bf16_t*)t.dst + (size_t)(t.rho0 + n) * D + t.k0 + 8 * kc) = o; }
    }
    asm volatile("s_waitcnt lgkmcnt(0)" ::: "memory");
}
struct In { const float* p[17]; };
DEVI const float* inptr(const Ctx& c, int i) {
    const LAS unsigned* q = (const LAS unsigned*)(c.lds + LDSCTL_OFF + LC_PTRS + 8 * i);
    const unsigned lo = __builtin_amdgcn_readfirstlane(q[0]), hi = __builtin_amdgcn_readfirstlane(q[1]);
    return (const float*)(((unsigned long long)hi << 32) | lo);
}

DEVI void p0_prologue(const Ctx& c0, unsigned char* ws) {
    const Ctx c = refresh(c0);
    const int gw = c.v * 8 + c.wave, NGW = c.G * 8;
    {
        LAS float* scr = (LAS float*)(c.lds + c.wave * 16896);
        constexpr int I_GU = 16 * 32, I_D = 16 * 16, N_GU = 64 * I_GU, N_D = 64 * I_D, I_QKV = 16 * 24, I_O = 16 * 16;
        constexpr int NIT = N_GU + N_D + I_QKV + I_O;
        const int lr = c.lane >> 4, lq = c.lane & 15;
        auto decode = [&](int it, TrItem& t) {
            int r = it; const float* W; int ldw, ca, cb;
            bool wide = false;
            if (r < N_GU) {
                const int le = r / I_GU, q = r % I_GU; t.f8 = (le >> 5) ? F8L1 : F8L0; wide = t.f8;
                const int kb = wide ? (q >> 6) : (q >> 5), rb = wide ? (q & 63) : (q & 31), rho0 = wide ? rb * 32 : rb * 64;
                const int pn = rho0 >> 8, bj = (rho0 >> 7) & 1, i = rho0 & 127, c0 = bj * 1024 + pn * 128 + i;
                t.dst = ws + WS_WGU + (size_t)(le >> 5) * 128 * MiB + (size_t)(le & 31) * 2048 * D * (t.f8 ? 1 : 2);
                W = inptr(c, 12) + (size_t)le * D * 2048; ldw = 2048; ca = c0; cb = c0 + 32; t.k0 = kb * (wide ? 128 : 64); t.rho0 = rho0;
            } else if ((r -= N_GU) < N_D) {
                const int le = r / I_D, q = r % I_D; t.f8 = (le >> 5) ? F8L1 : F8L0; wide = t.f8;
                const int kb = wide ? (q >> 5) : (q >> 4), rb = wide ? (q & 31) : (q & 15), rho0 = wide ? rb * 32 : rb * 64;
                t.dst = ws + WS_WD + (size_t)(le >> 5) * 64 * MiB + (size_t)(le & 31) * D * D * (t.f8 ? 1 : 2);
                W = inptr(c, 14) + (size_t)le * D * D; ldw = D; ca = rho0; cb = ca + 32; t.k0 = kb * (wide ? 128 : 64); t.rho0 = rho0;
            } else if ((r -= N_D) < I_QKV) {
                const int kb = r / 24, rb = r % 24, p0 = rb * 64; ca = p0; cb = p0 + 32;
                if (p0 < 1280) { const int pn = p0 >> 8, bj = (p0 >> 7) & 1, q = p0 & 127; ca = pn * 256 + (q >> 5) * 64 + 32 * bj; cb = ca + 64; }
                t.f8 = false; t.dst = ws + WS_WQKV; W = inptr(c, 5); ldw = QKVD; t.k0 = kb * 64; t.rho0 = p0;
            } else {
                r -= I_QKV; const int kb = r >> 4, rb = r & 15;
                t.f8 = false; t.dst = ws + WS_WO; W = inptr(c, 8); ldw = D; ca = rb * 64; cb = ca + 32; t.k0 = kb * 64; t.rho0 = rb * 64;
            }
            if (wide) { t.src = W + (size_t)(t.k0 + (c.lane >> 3)) * ldw + ca + 4 * (c.lane & 7); t.ldw4 = (size_t)8 * ldw; }
            else { t.src = W + (size_t)(t.k0 + lr) * ldw + ((lq < 8) ? ca + 4 * lq : cb + 4 * (lq - 8)); t.ldw4 = (size_t)4 * ldw; }
        };
        TrItem cur, nxt; f32x4 va[16], vb[16];
        if (gw < NIT) { decode(gw, cur); tr_load(cur, va); }
        for (int it = gw; it < NIT; it += NGW) {
            const bool hn = it + NGW < NIT;
            if (hn) { decode(it + NGW, nxt); tr_load(nxt, vb); }
            tr_finish(cur, va, scr, c.lane);
            if (hn) { cur = nxt;
#pragma unroll
                for (int i = 0; i < 16; ++i) va[i] = vb[i]; }
        }
    }
    __syncthreads();
    LAS float* tab = (LAS float*)c.lds; LAS float* tab128 = tab + 4096;
    for (int k = c.tid; k < 4096; k += 512) tab[k] = cospif((float)k * (1.0f / 2048.0f));
    if (c.tid < 128) tab128[c.tid] = cospif((float)c.tid * (1.0f / 64.0f));
    __syncthreads();
    {
        float* TW = (float*)(ws + WS_TW);
        const int gt = c.v * 512 + c.tid;
        if (gt < 4096) { const int k1 = gt >> 6, bb = gt & 63; const float a = (float)(k1 * bb) * (1.0f / 2048.0f); TW[2 * gt] = cospif(a); TW[2 * gt + 1] = sinpif(a); }
    }
    {
        const float* wo = inptr(c, 3); bf16_t* WP = (bf16_t*)(ws + WS_WP);
        const float scale = 1.0f / sqrtf((float)SEQ * 128.0f);
        const int l15 = c.lane & 15, kq = c.lane >> 4;
        for (int task = c.wave * c.G + c.v; task < 1024; task += 8 * c.G) {
            const int half = task >> 9, g = (task >> 6) & 7, nb = task & 63;
            const float* wsrc = wo + (size_t)(g * 128 + kq) * D + nb * 16 + l15;
            float bvv[32];
#pragma unroll
            for (int ks = 0; ks < 32; ++ks) bvv[ks] = wsrc[(size_t)(4 * ks) * D];
            f32x4 a[8];
#pragma unroll
            for (int ccb = 0; ccb < 8; ++ccb) a[ccb] = (f32x4){0.f, 0.f, 0.f, 0.f};
#pragma unroll
            for (int ks = 0; ks < 32; ++ks) {
                const int cp = 4 * ks + kq;
#pragma unroll
                for (int ccb = 0; ccb < 8; ++ccb) {
                    const float tv = tab128[((ccb * 16 + l15) * cp - (half ? 32 : 0)) & 127];
                    a[ccb] = __builtin_amdgcn_mfma_f32_16x16x4f32(tv, bvv[ks], a[ccb], 0, 0, 0);
                }
            }
            const float sg = half ? -scale : scale;
            bf16_t* dst = WP + (size_t)half * D * D + (size_t)(nb * 16 + l15) * D + g * 128 + 4 * kq;
#pragma unroll
            for (int ccb = 0; ccb < 8; ++ccb) { u32x2 o; o.x = pk2(a[ccb][0] * sg, a[ccb][1] * sg); o.y = pk2(a[ccb][2] * sg, a[ccb][3] * sg); *(u32x2*)(dst + ccb * 16) = o; }
        }
    }
    {
        float* cosT = (float*)(ws + WS_COS); float* sinT = (float*)(ws + WS_SIN);
        const int gt = c.v * 512 + c.tid, NT_ = c.G * 512;
        for (int i = gt; i < SEQ * 32; i += NT_) {
            const int s = i >> 5, j = i & 31;
            const float inv_freq = powf(10000.0f, -(float)(2 * j) / 64.0f);
            const float ang = (float)s * inv_freq;
            cosT[i] = cosf(ang); sinT[i] = sinf(ang);
        }
    }
    __syncthreads();
    {
        const float* x = inptr(c, 0); const float* g = inptr(c, 1); bf16_t* HT = (bf16_t*)(ws + WS_HT);
        LAS bf16_t* tile = (LAS bf16_t*)c.lds; constexpr int TS = 1026;
        f32x4 gg[4];
#pragma unroll
        for (int j = 0; j < 4; ++j) gg[j] = *((const f32x4*)g + c.lane + 64 * j);
        for (int blk = c.v; blk < T / 64; blk += c.G) {
            const int bat = blk >> 6, b0 = blk & 63;
            f32x4 va[4][4], vb[4][4];
#pragma unroll
            for (int i = 0; i < 4; ++i) { const f32x4* xr = (const f32x4*)(x + ((size_t)bat * SEQ + 64 * (c.wave * 8 + i) + b0) * D) + c.lane;
#pragma unroll
                for (int j = 0; j < 4; ++j) va[i][j] = __builtin_nontemporal_load(xr + 64 * j); }
#pragma unroll
            for (int i = 0; i < 4; ++i) { const f32x4* xr = (const f32x4*)(x + ((size_t)bat * SEQ + 64 * (c.wave * 8 + 4 + i) + b0) * D) + c.lane;
#pragma unroll
                for (int j = 0; j < 4; ++j) vb[i][j] = __builtin_nontemporal_load(xr + 64 * j); }
#pragma unroll
            for (int i = 0; i < 8; ++i) {
                const int tl = c.wave * 8 + i;
                f32x4 v[4]; float s = 0.f;
#pragma unroll
                for (int j = 0; j < 4; ++j) { v[j] = (i < 4) ? va[i & 3][j] : vb[i & 3][j]; s += v[j].x * v[j].x + v[j].y * v[j].y + v[j].z * v[j].z + v[j].w * v[j].w; }
                const float r = rsqrtf(wave_sum(s) * (1.0f / D) + RMS_EPS);
#pragma unroll
                for (int j = 0; j < 4; ++j) {
                    u32x2 w; w.x = pk2(v[j].x * r * gg[j].x, v[j].y * r * gg[j].y); w.y = pk2(v[j].z * r * gg[j].z, v[j].w * r * gg[j].w);
                    LAS unsigned* tp = (LAS unsigned*)(tile + tl * TS + 256 * j + 4 * c.lane); tp[0] = w.x; tp[1] = w.y;
                }
            }
            __syncthreads();
            for (int it = c.tid; it < 1024 * 8; it += 512) {
                const int o8 = it & 7, ch = it >> 3;
                unsigned short e[8];
#pragma unroll
                for (int j = 0; j < 8; ++j) e[j] = tile[(o8 * 8 + j) * TS + ch];
                u32x4 o; o.x = e[0] | ((unsigned)e[1] << 16); o.y = e[2] | ((unsigned)e[3] << 16); o.z = e[4] | ((unsigned)e[5] << 16); o.w = e[6] | ((unsigned)e[7] << 16);
                *(u32x4*)(HT + (((size_t)bat * D + ch) * 64 + b0) * 64 + o8 * 8) = o;
            }
            __syncthreads();
        }
    }
}

struct F64Frags { bf16x8 C[2][4], S[2][4]; };
DEVI void make_f64(const Ctx& c, F64Frags& f) {
    LAS float* tab = (LAS float*)c.lds;
    __syncthreads();
    if (c.tid < 64) tab[c.tid] = cospif((float)c.tid * (1.0f / 32.0f));
    __syncthreads();
    const int r32 = c.lane & 31, hi = c.lane >> 5;
#pragma unroll
    for (int t = 0; t < 2; ++t)
#pragma unroll
        for (int ks = 0; ks < 4; ++ks) {
            union { bf16x8 v; unsigned w[4]; } cv, sv;
#pragma unroll
            for (int j = 0; j < 4; ++j) {
                const int q = r32 + 32 * t, k0 = 16 * ks + 8 * hi + 2 * j, i0 = (q * k0) & 63, i1 = (q * (k0 + 1)) & 63;
                cv.w[j] = pk2(tab[i0], tab[i1]); sv.w[j] = pk2(tab[(i0 - 16) & 63], tab[(i1 - 16) & 63]);
            }
            f.C[t][ks] = cv.v; f.S[t][ks] = sv.v;
        }
}
constexpr int FFT_STG = 2 * 64 * 33 * 4;
static_assert(8 * FFT_STG <= LDSCTL_OFF, "fft stage fits under the LDS control area");
DEVI void fft1_phase(const Ctx& c0, const bf16_t* HT2, const float* TW, bf16_t* Y2) {
    const Ctx c = refresh(c0);
    F64Frags f; make_f64(c, f);
    __syncthreads();
    LAS unsigned* stg = (LAS unsigned*)(c.lds + c.wave * FFT_STG);
    const int r32 = c.lane & 31, hi = c.lane >> 5;
    const int gw = c.v * 8 + c.wave, NGW = c.G * 8;
    bf16x8 xn[4];
    if (gw < BATCH * D) {
#pragma unroll
        for (int ks = 0; ks < 4; ++ks) xn[ks] = __builtin_nontemporal_load((const bf16x8*)(HT2 + (size_t)gw * 4096 + r32 * 64 + 16 * ks + 8 * hi));
    }
    for (int item = gw; item < BATCH * D; item += NGW) {
        const int bat = item >> 10, ch = item & 1023;
#pragma unroll 1
        for (int bt = 0; bt < 2; ++bt) {
            bf16x8 xf[4];
#pragma unroll
            for (int ks = 0; ks < 4; ++ks) xf[ks] = xn[ks];
            {
                const int nitem = bt ? item + NGW : item, nbt = bt ^ 1;
                if (nitem < BATCH * D) {
#pragma unroll
                    for (int ks = 0; ks < 4; ++ks) xn[ks] = __builtin_nontemporal_load((const bf16x8*)(HT2 + (size_t)nitem * 4096 + (32 * nbt + r32) * 64 + 16 * ks + 8 * hi));
                }
            }
            f32x16 P[2], Q[2];
#pragma unroll
            for (int kt = 0; kt < 2; ++kt) {
#pragma unroll
                for (int i = 0; i < 16; ++i) { P[kt][i] = 0.f; Q[kt][i] = 0.f; }
#pragma unroll
                for (int ks = 0; ks < 4; ++ks) {
                    P[kt] = __builtin_amdgcn_mfma_f32_32x32x16_bf16(xf[ks], f.C[kt][ks], P[kt], 0, 0, 0);
                    Q[kt] = __builtin_amdgcn_mfma_f32_32x32x16_bf16(xf[ks], f.S[kt][ks], Q[kt], 0, 0, 0);
                }
            }
#pragma unroll
            for (int kt = 0; kt < 2; ++kt) {
                const int k1 = r32 + 32 * kt;
#pragma unroll
                for (int i = 0; i < 4; ++i) {
                    const int b0 = 32 * bt + 8 * i + 4 * hi;
                    const f32x4 t0 = *(const f32x4*)(TW + (k1 * 64 + b0) * 2), t1 = *(const f32x4*)(TW + (k1 * 64 + b0) * 2 + 4);
                    const float cs[4] = {t0.x, t0.z, t1.x, t1.z}, sn[4] = {t0.y, t0.w, t1.y, t1.w};
                    float tr[4], ti[4];
#pragma unroll
                    for (int j = 0; j < 4; ++j) { const float pp = P[kt][4 * i + j], qq = Q[kt][4 * i + j]; tr[j] = pp * cs[j] - qq * sn[j]; ti[j] = pp * sn[j] + qq * cs[j]; }
                    LAS unsigned* sp = stg + k1 * 33 + (b0 >> 1);
                    sp[0] = pk2(tr[0], tr[1]); sp[1] = pk2(tr[2], tr[3]);
                    sp[64 * 33] = pk2(ti[0], ti[1]); sp[64 * 33 + 1] = pk2(ti[2], ti[3]);
                }
            }
        }
        asm volatile("s_waitcnt lgkmcnt(0)" ::: "memory");
#pragma unroll
        for (int it = 0; it < 16; ++it) {
            const int part = it >> 3, row = (it & 7) * 8 + (c.lane >> 3), chunk = c.lane & 7;
            const LAS unsigned* sp = stg + (part * 64 + row) * 33 + chunk * 4;
            u32x4 w; w.x = sp[0]; w.y = sp[1]; w.z = sp[2]; w.w = sp[3];
            *(u32x4*)(Y2 + ((((size_t)bat * 64 + row) * 2 + part) * 1024 + ch) * 64 + chunk * 8) = w;
        }
        asm volatile("s_waitcnt lgkmcnt(0)" ::: "memory");
    }
}
DEVI void fft2_phase(const Ctx& c0, const bf16_t* Y2, bf16_t* UB, bf16_t* VB, bf16_t* U2048) {
    const Ctx c = refresh(c0);
    F64Frags f; make_f64(c, f);
    __syncthreads();
    LAS unsigned* stg = (LAS unsigned*)(c.lds + c.wave * FFT_STG);
    const int r32 = c.lane & 31, hi = c.lane >> 5;
    const int gw = c.v * 8 + c.wave, NGW = c.G * 8;
    bf16x8 trn[4], tin[4];
#define F2_ADDR(it_, sub_) (Y2 + (((((size_t)((it_) >> 10)) * 64 + (((it_) >> 4) & 63)) * 2) * 1024 + 64 * ((it_) & 15) + 32 * (sub_) + r32) * 64 + 8 * hi)
    if (gw < BATCH * 64 * 16) {
        const bf16_t* yb = F2_ADDR(gw, 0);
#pragma unroll
        for (int ks = 0; ks < 4; ++ks) { trn[ks] = __builtin_nontemporal_load((const bf16x8*)(yb + 16 * ks)); tin[ks] = __builtin_nontemporal_load((const bf16x8*)(yb + 1024 * 64 + 16 * ks)); }
    }
    for (int item = gw; item < BATCH * 64 * 16; item += NGW) {
        const int ct = item & 15, k1 = (item >> 4) & 63, bat = item >> 10, c0 = 64 * ct;
#pragma unroll 1
        for (int sub = 0; sub < 2; ++sub) {
            bf16x8 trf[4], tif[4], ntf[4];
#pragma unroll
            for (int ks = 0; ks < 4; ++ks) { trf[ks] = trn[ks]; tif[ks] = tin[ks]; ntf[ks] = tif[ks] ^ (short)0x8000; }
            {
                const int nitem = sub ? item + NGW : item, nsub = sub ^ 1;
                if (nitem < BATCH * 64 * 16) {
                    const bf16_t* yb = F2_ADDR(nitem, nsub);
#pragma unroll
                    for (int ks = 0; ks < 4; ++ks) { trn[ks] = __builtin_nontemporal_load((const bf16x8*)(yb + 16 * ks)); tin[ks] = __builtin_nontemporal_load((const bf16x8*)(yb + 1024 * 64 + 16 * ks)); }
                }
            }
            f32x16 U[2], V[2];
            const int nkt = (k1 == 0) ? 2 : 1;
#pragma unroll
            for (int kt = 0; kt < 2; ++kt) {
                if (kt >= nkt) break;
#pragma unroll
                for (int i = 0; i < 16; ++i) { U[kt][i] = 0.f; V[kt][i] = 0.f; }
#pragma unroll
                for (int ks = 0; ks < 4; ++ks) {
                    U[kt] = __builtin_amdgcn_mfma_f32_32x32x16_bf16(trf[ks], f.C[kt][ks], U[kt], 0, 0, 0);
                    U[kt] = __builtin_amdgcn_mfma_f32_32x32x16_bf16(ntf[ks], f.S[kt][ks], U[kt], 0, 0, 0);
                    V[kt] = __builtin_amdgcn_mfma_f32_32x32x16_bf16(tif[ks], f.C[kt][ks], V[kt], 0, 0, 0);
                    V[kt] = __builtin_amdgcn_mfma_f32_32x32x16_bf16(trf[ks], f.S[kt][ks], V[kt], 0, 0, 0);
                }
            }
#pragma unroll
            for (int kt = 0; kt < 2; ++kt) {
                if (kt >= nkt) break;
#pragma unroll
                for (int i = 0; i < 4; ++i) {
                    LAS unsigned* sp = stg + (r32 + 32 * kt) * 33 + ((32 * sub + 8 * i + 4 * hi) >> 1);
                    sp[0] = pk2(U[kt][4 * i], U[kt][4 * i + 1]); sp[1] = pk2(U[kt][4 * i + 2], U[kt][4 * i + 3]);
                    sp[64 * 33] = pk2(V[kt][4 * i], V[kt][4 * i + 1]); sp[64 * 33 + 1] = pk2(V[kt][4 * i + 2], V[kt][4 * i + 3]);
                }
            }
        }
        asm volatile("s_waitcnt lgkmcnt(0)" ::: "memory");
#pragma unroll
        for (int it = 0; it < 8; ++it) {
            const int part = it >> 2, row = (it & 3) * 8 + (c.lane >> 3), chunk = c.lane & 7;
            const LAS unsigned* sp = stg + (part * 64 + row) * 33 + chunk * 4;
            u32x4 w; w.x = sp[0]; w.y = sp[1]; w.z = sp[2]; w.w = sp[3];
            *(u32x4*)((part ? VB : UB) + ((size_t)bat * 2048 + k1 + 64 * row) * D + c0 + chunk * 8) = w;
        }
        if (k1 == 0 && c.lane < 8) {
            const LAS unsigned* sp = stg + 32 * 33 + c.lane * 4;
            u32x4 w; w.x = sp[0]; w.y = sp[1]; w.z = sp[2]; w.w = sp[3];
            *(u32x4*)(U2048 + (size_t)bat * D + c0 + c.lane * 8) = w;
        }
        asm volatile("s_waitcnt lgkmcnt(0)" ::: "memory");
    }
#undef F2_ADDR
}

template <bool F8>
DEVI void router_phase(const Ctx& c0, const bf16_t* X, const float* g, const float* rw, const float* rb, unsigned char* HN, int* idx, float* gate, int* rank, unsigned* cnt, int* bbase, int* slot_tok) {
    const Ctx c = refresh(c0);
    for (int i = c.v * 512 + c.tid; i < NSLOT; i += c.G * 512) slot_tok[i] = 0;
    LAS float* wg = (LAS float*)c.lds;
    LAS int* hist = (LAS int*)(c.lds + LDSCTL_OFF + LC_HIST);
    for (int it = c.tid; it < 8192; it += 512) { const f32x4 w = *((const f32x4*)rw + it); const float gd = g[it >> 3]; *((LAS f32x4*)wg + it) = w * gd; }
    if (c.tid < 32) hist[c.tid] = 0;
    __syncthreads();
    f32x4 gg[2][2];
#pragma unroll
    for (int jj = 0; jj < 2; ++jj) { gg[jj][0] = *(const f32x4*)(g + 512 * jj + 8 * c.lane); gg[jj][1] = *(const f32x4*)(g + 512 * jj + 8 * c.lane + 4); }
    const int tl = c.lane & 15, q = c.lane >> 4;
    const bool hi32 = c.lane >= 32;
    for (int ci = c.v; ci < T / 128; ci += c.G) {
        const int t0 = ci * 128 + c.wave * 16;
        const bf16_t* xp = X + (size_t)(t0 + tl) * D + 8 * q;
        const LAS float* wp = wg + (8 * q) * 32 + 2 * tl;
        f32x4 acc0 = {0.f, 0.f, 0.f, 0.f}, acc1 = {0.f, 0.f, 0.f, 0.f};
        float ss = 0.f;
        u32x4 xa[4], xb[4];
#pragma unroll
        for (int u = 0; u < 4; ++u) xa[u] = *(const u32x4*)(xp + 32 * u);
#pragma unroll 1
        for (int jb = 0; jb < 8; ++jb) {
            if (jb < 7) {
#pragma unroll
                for (int u = 0; u < 4; ++u) xb[u] = *(const u32x4*)(xp + 32 * (4 * (jb + 1) + u));
            }
#pragma unroll
            for (int u = 0; u < 4; ++u) {
                const u32x4 xw = xa[u]; const int U = 4 * jb + u;
                const float xv[8] = {bflo(xw.x), bfhi(xw.x), bflo(xw.y), bfhi(xw.y), bflo(xw.z), bfhi(xw.z), bflo(xw.w), bfhi(xw.w)};
#pragma unroll
                for (int i = 0; i < 8; ++i) {
                    ss += xv[i] * xv[i];
                    const f32x2 w2 = *(const LAS f32x2*)(wp + (32 * U + i) * 32);
                    acc0 = __builtin_amdgcn_mfma_f32_16x16x4f32(w2.x, xv[i], acc0, 0, 0, 0);
                    acc1 = __builtin_amdgcn_mfma_f32_16x16x4f32(w2.y, xv[i], acc1, 0, 0, 0);
                }
            }
#pragma unroll
            for (int u = 0; u < 4; ++u) xa[u] = xb[u];
        }
        ss += xor_f32<16>(ss, hi32); ss += xor_f32<32>(ss, hi32);
        const float r = rsqrtf(ss * (1.0f / D) + RMS_EPS);
        float lv[8];
#pragma unroll
        for (int rr = 0; rr < 4; ++rr) { lv[2 * rr] = acc0[rr] * r + rb[2 * (4 * q + rr)]; lv[2 * rr + 1] = acc1[rr] * r + rb[2 * (4 * q + rr) + 1]; }
        float topv[4]; int topi[4];
#pragma unroll
        for (int k = 0; k < 4; ++k) {
            float bv = lv[0]; int bi = 8 * q;
#pragma unroll
            for (int n = 1; n < 8; ++n) if (lv[n] > bv) { bv = lv[n]; bi = 8 * q + n; }
#define AM_STEP(O) { const float ov = xor_f32<O>(bv, hi32); const int oi = (int)xor_u32<O>((unsigned)bi, hi32); if (ov > bv || (ov == bv && oi < bi)) { bv = ov; bi = oi; } }
            AM_STEP(16) AM_STEP(32)
#undef AM_STEP
            topv[k] = bv; topi[k] = bi;
#pragma unroll
            for (int n = 0; n < 8; ++n) if (bi == 8 * q + n) lv[n] = -INFINITY;
        }
        float ex[4], sum = 0.f;
#pragma unroll
        for (int k = 0; k < 4; ++k) { ex[k] = __expf(topv[k] - topv[0]); sum += ex[k]; }
        if (c.lane < 16) {
            const int t = t0 + tl; const float inv = 1.0f / sum;
#pragma unroll
            for (int k = 0; k < 4; ++k) { idx[t * 4 + k] = topi[k]; gate[t * 4 + k] = ex[k] * inv; rank[t * 4 + k] = __hip_atomic_fetch_add(&hist[topi[k]], 1, __ATOMIC_RELAXED, __HIP_MEMORY_SCOPE_WORKGROUP); }
        }
#pragma unroll 8
        for (int i = 0; i < 16; ++i) {
            const float ri = __builtin_bit_cast(float, __builtin_amdgcn_readlane(__builtin_bit_cast(int, r), i));
            const int t = t0 + i;
#pragma unroll
            for (int jj = 0; jj < 2; ++jj) {
                const u32x4 xw = *(const u32x4*)(X + (size_t)t * D + 512 * jj + 8 * c.lane);
                const f32x4 h0 = (f32x4){bflo(xw.x), bfhi(xw.x), bflo(xw.y), bfhi(xw.y)} * ri * gg[jj][0], h1 = (f32x4){bflo(xw.z), bfhi(xw.z), bflo(xw.w), bfhi(xw.w)} * ri * gg[jj][1];
                if (F8) { u32x2 w; w.x = pk4f8(h0[0], h0[1], h0[2], h0[3]); w.y = pk4f8(h1[0], h1[1], h1[2], h1[3]); *(u32x2*)(HN + (size_t)t * D + 512 * jj + 8 * c.lane) = w; }
                else { u32x4 w; w.x = pk2(h0[0], h0[1]); w.y = pk2(h0[2], h0[3]); w.z = pk2(h1[0], h1[1]); w.w = pk2(h1[2], h1[3]); *(u32x4*)(HN + ((size_t)t * D + 512 * jj + 8 * c.lane) * 2) = w; }
            }
        }
        __syncthreads();
        if (c.tid < 32) { const int h = hist[c.tid]; bbase[ci * 32 + c.tid] = (int)__hip_atomic_fetch_add(&cnt[c.tid], (unsigned)h, RLX_AGENT); hist[c.tid] = 0; }
        __syncthreads();
    }
}

DEVI void moe_plan(const Ctx& c0, const unsigned* cnt) {
    const Ctx c = refresh(c0);
    LAS int* pst = (LAS int*)(c.lds + LDSCTL_OFF + LC_PST); LAS int* ntl = (LAS int*)(c.lds + LDSCTL_OFF + LC_NT); LAS int* tile_e = (LAS int*)(c.lds + LDSCTL_OFF + LC_TILEE);
    if (c.tid < 64) {
        const int e = c.tid; const int cn = (e < NE) ? (int)__hip_atomic_load(&cnt[e], RLX_AGENT) : 0;
        const int padded = ((cn + MT - 1) / MT) * MT;
        if (e < NE) pst[e] = padded;
        asm volatile("s_waitcnt lgkmcnt(0)" ::: "memory");
        int st = 0;
        for (int j = 0; j < NE; ++j) { const int pj = pst[j]; st += (j < e) ? pj : 0; }
        asm volatile("s_waitcnt lgkmcnt(0)" ::: "memory");
        const int incl = st + padded;
        if (e < NE) { pst[e] = st; for (int i = st / MT; i < incl / MT; ++i) tile_e[i] = e; if (e == NE - 1) ntl[0] = incl / MT; }
    }
    __syncthreads();
}

DEVI void scatter_phase(const Ctx& c0, const unsigned* cnt, const int* idx, const int* rank, const int* bbase, int* slot_of, int* slot_tok) {
    const Ctx c = refresh(c0);
    moe_plan(c, cnt);
    const LAS int* pst = (const LAS int*)(c.lds + LDSCTL_OFF + LC_PST);
    for (int ci = c.v; ci < T / 128; ci += c.G) {
        const int i = ci * 512 + c.tid;
        const int e = idx[i], slot = pst[e] + bbase[ci * 32 + e] + rank[i];
        slot_of[i] = slot; slot_tok[slot] = i >> 2;
    }
}

template <bool FINAL>
DEVI void combine_phase(const Ctx& c0, bf16_t* X, const bf16_t* Y, const float* gate, const int* slot_of, const float* gn, bf16_t* HN, float* OUT) {
    const Ctx c = refresh(c0);
    const int gw = c.v * 8 + c.wave, NGW = c.G * 8;
    f32x4 gg[2][2];
#pragma unroll
    for (int jj = 0; jj < 2; ++jj) { gg[jj][0] = *(const f32x4*)(gn + 512 * jj + 8 * c.lane); gg[jj][1] = *(const f32x4*)(gn + 512 * jj + 8 * c.lane + 4); }
    for (int blk = gw; blk < T / 16; blk += NGW) {
        const int t0 = blk * 16;
        const int myslot = slot_of[t0 * 4 + c.lane]; const float mygate = gate[t0 * 4 + c.lane];
#pragma unroll 1
        for (int i = 0; i < 16; i += 2) {
            f32x4 v[2][2][2]; u32x4 y[2][4][2];
#pragma unroll
            for (int u = 0; u < 2; ++u) {
                const bf16_t* xr = X + (size_t)(t0 + i + u) * D + 8 * c.lane;
#pragma unroll
                for (int jj = 0; jj < 2; ++jj) { const u32x4 xw = *(const u32x4*)(xr + 512 * jj); v[u][jj][0] = (f32x4){bflo(xw.x), bfhi(xw.x), bflo(xw.y), bfhi(xw.y)}; v[u][jj][1] = (f32x4){bflo(xw.z), bfhi(xw.z), bflo(xw.w), bfhi(xw.w)}; }
#pragma unroll
                for (int k = 0; k < 4; ++k) {
                    const int slot = __builtin_amdgcn_readlane(myslot, (i + u) * 4 + k);
                    const unsigned char* yr = (const unsigned char*)Y + (size_t)slot * D + 8 * c.lane;
                    const u32x2 ya = __builtin_nontemporal_load((const u32x2*)yr), yb = __builtin_nontemporal_load((const u32x2*)(yr + 512));
                    y[u][k][0] = (u32x4){ya.x, ya.y, 0u, 0u}; y[u][k][1] = (u32x4){yb.x, yb.y, 0u, 0u};
                }
            }
#pragma unroll
            for (int u = 0; u < 2; ++u) {
                const int t = t0 + i + u;
#pragma unroll
                for (int k = 0; k < 4; ++k) {
                    const float gk = __builtin_bit_cast(float, __builtin_amdgcn_readlane(__builtin_bit_cast(int, mygate), (i + u) * 4 + k));
#pragma unroll
                    for (int jj = 0; jj < 2; ++jj) {
                        const u32x4 yy = y[u][k][jj];
                        const f32x2 p0 = __builtin_amdgcn_cvt_pk_f32_fp8((int)yy.x, false), p1 = __builtin_amdgcn_cvt_pk_f32_fp8((int)yy.x, true), p2 = __builtin_amdgcn_cvt_pk_f32_fp8((int)yy.y, false), p3 = __builtin_amdgcn_cvt_pk_f32_fp8((int)yy.y, true);
                        v[u][jj][0].x += gk * p0.x; v[u][jj][0].y += gk * p0.y; v[u][jj][0].z += gk * p1.x; v[u][jj][0].w += gk * p1.y;
                        v[u][jj][1].x += gk * p2.x; v[u][jj][1].y += gk * p2.y; v[u][jj][1].z += gk * p3.x; v[u][jj][1].w += gk * p3.y;
                    }
                }
                float s = 0.f;
#pragma unroll
                for (int jj = 0; jj < 2; ++jj)
#pragma unroll
                    for (int h = 0; h < 2; ++h) { const f32x4 a = v[u][jj][h]; s += a.x * a.x + a.y * a.y + a.z * a.z + a.w * a.w; }
                const float r = rsqrtf(wave_sum(s) * (1.0f / D) + RMS_EPS);
                bf16_t* xr = X + (size_t)t * D + 8 * c.lane;
#pragma unroll
                for (int jj = 0; jj < 2; ++jj) {
                    const f32x4 a0 = v[u][jj][0] * r * gg[jj][0], a1 = v[u][jj][1] * r * gg[jj][1];
                    if (FINAL) { float* o = OUT + (size_t)t * D + 8 * c.lane + 512 * jj; *(f32x4*)o = a0; *(f32x4*)(o + 4) = a1; }
                    else {
                        { const f32x4 x0 = v[u][jj][0], x1 = v[u][jj][1]; u32x4 xw; xw.x = pk2(x0.x, x0.y); xw.y = pk2(x0.z, x0.w); xw.z = pk2(x1.x, x1.y); xw.w = pk2(x1.z, x1.w); *(u32x4*)(xr + 512 * jj) = xw; }
                        u32x4 w; w.x = pk2(a0.x, a0.y); w.y = pk2(a0.z, a0.w); w.z = pk2(a1.x, a1.y); w.w = pk2(a1.z, a1.w);
                        *(u32x4*)(HN + (size_t)t * D + 8 * c.lane + 512 * jj) = w;
                    }
                }
            }
        }
    }
}

constexpr int AT_KOFF = 0, AT_VOFF = 49152, AT_VS = 776;
DEVI void attn_phase(const Ctx& c0, const bf16_t* Q, const bf16_t* Kb, const bf16_t* VT, const float* sink, bf16_t* O) {
    const Ctx c = refresh(c0);
    LAS unsigned char* lds = c.lds;
    const int r32 = c.lane & 31, hi = c.lane >> 5;
    for (int L = c.v; L < 1024; L += c.G) {
        const int b = L >> 7, kv = (L >> 5) & 3, qb = L & 31;
        const int kpos0 = (qb - 1) * 128;
        __syncthreads();
        for (int ch = c.tid; ch < 3072; ch += 512) {
            const int row = ch >> 3, cc = ch & 7, kpos = kpos0 + row;
            if (kpos >= 0 && kpos < SEQ) {
                const u32x4 v = *(const u32x4*)(Kb + (size_t)(b * SEQ + kpos) * 256 + kv * 64 + cc * 8);
                *(LAS u32x4*)(lds + AT_KOFF + row * 128 + ((cc ^ ((row >> 1) & 7)) << 4)) = v;
            }
        }
        for (int ch = c.tid; ch < 3072; ch += 512) {
            const int d = ch / 48, kc = ch % 48, kpos = kpos0 + kc * 8;
            if (kpos >= 0 && kpos < SEQ) {
                const u32x4 v = *(const u32x4*)(VT + (size_t)(kv * 64 + d) * T + b * SEQ + kpos);
                LAS u32x2* dp = (LAS u32x2*)(lds + AT_VOFF + d * AT_VS + kc * 16);
                dp[0] = (u32x2){v.x, v.y}; dp[1] = (u32x2){v.z, v.w};
            }
        }
        __syncthreads();
        const int g = c.wave >> 1, hq = kv * 4 + g;
        const float snk = sink[hq];
        const int jlo = (qb == 0) ? 1 : 0, jhi = (qb == 31) ? 2 : 3;
        for (int qc = 0; qc < 2; ++qc) {
            const int ql0 = (c.wave & 1) * 64 + qc * 32;
            const size_t trow = (size_t)b * SEQ + qb * 128 + ql0 + r32;
            bf16x8 qf[4];
#pragma unroll
            for (int ks = 0; ks < 4; ++ks) qf[ks] = *(const bf16x8*)(Q + trow * D + hq * 64 + ks * 16 + hi * 8);
            float m = snk * 1.4426950408889634f, l = 1.0f;
            f32x16 o0, o1;
#pragma unroll
            for (int i = 0; i < 16; ++i) { o0[i] = 0.f; o1[i] = 0.f; }
            const int qc4 = ql0 >> 5;
            for (int jb = jlo; jb < jhi; ++jb) {
                f32x16 s[4];
#pragma unroll
                for (int kt = 0; kt < 4; ++kt) {
                    const bool act = (jb == 1) || (jb == 0 ? kt >= qc4 : kt <= qc4);
                    if (act) {
#pragma unroll
                        for (int i = 0; i < 16; ++i) s[kt][i] = 0.f;
                        const int row = jb * 128 + kt * 32 + r32;
#pragma unroll
                        for (int ks = 0; ks < 4; ++ks) {
                            const bf16x8 kf = *(const LAS bf16x8*)(lds + AT_KOFF + row * 128 + (((2 * ks + hi) ^ ((row >> 1) & 7)) << 4));
                            s[kt] = __builtin_amdgcn_mfma_f32_32x32x16_bf16(kf, qf[ks], s[kt], 0, 0, 0);
                        }
                    }
                }
                float mx = -1e30f;
#pragma unroll
                for (int kt = 0; kt < 4; ++kt) {
                    const bool act = (jb == 1) || (jb == 0 ? kt >= qc4 : kt <= qc4);
                    if (act) {
                        if (jb != 1 && kt == qc4) {
                            const int sg = (jb == 0) ? 1 : -1;
                            int tq = sg * (4 * hi - r32); asm volatile("" : "+v"(tq));
#pragma unroll
                            for (int i = 0; i < 16; ++i) {
                                const int kc = (i & 3) + 8 * (i >> 2);
                                const float sv = (sg * kc + tq >= 0) ? s[kt][i] : -1e30f;
                                s[kt][i] = sv; mx = fmaxf(mx, sv);
                            }
                        } else {
#pragma unroll
                            for (int i = 0; i < 16; ++i) mx = fmaxf(mx, s[kt][i]);
                        }
                    }
                }
                mx = max32(mx);
                const float mn = fmaxf(m, mx), alpha = __builtin_amdgcn_exp2f(m - mn);
                float ps = 0.f;
#pragma unroll
                for (int kt = 0; kt < 4; ++kt) {
                    const bool act = (jb == 1) || (jb == 0 ? kt >= qc4 : kt <= qc4);
                    if (act) {
#pragma unroll
                        for (int i = 0; i < 16; ++i) { const float pv = __builtin_amdgcn_exp2f(s[kt][i] - mn); s[kt][i] = pv; ps += pv; }
                    }
                }
                ps = sum32(ps);
                l = l * alpha + ps; m = mn;
#pragma unroll
                for (int i = 0; i < 16; ++i) { o0[i] *= alpha; o1[i] *= alpha; }
#pragma unroll
                for (int kt = 0; kt < 4; ++kt) {
                    const bool act = (jb == 1) || (jb == 0 ? kt >= qc4 : kt <= qc4);
                    if (act) {
#pragma unroll
                        for (int s2 = 0; s2 < 2; ++s2) {
                            union { bf16x8 v; unsigned w[4]; } pf;
#pragma unroll
                            for (int j = 0; j < 4; ++j) pf.w[j] = pk2(s[kt][8 * s2 + 2 * j], s[kt][8 * s2 + 2 * j + 1]);
                            const int key = jb * 128 + kt * 32 + s2 * 16 + 4 * hi;
#pragma unroll
                            for (int dt = 0; dt < 2; ++dt) {
                                const LAS unsigned char* vp = lds + AT_VOFF + (dt * 32 + r32) * AT_VS + key * 2;
                                union { bf16x8 v; u32x2 h[2]; } vf;
                                vf.h[0] = *(const LAS u32x2*)vp; vf.h[1] = *(const LAS u32x2*)(vp + 16);
                                if (dt == 0) o0 = __builtin_amdgcn_mfma_f32_32x32x16_bf16(vf.v, pf.v, o0, 0, 0, 0);
                                else o1 = __builtin_amdgcn_mfma_f32_32x32x16_bf16(vf.v, pf.v, o1, 0, 0, 0);
                            }
                        }
                    }
                }
            }
            const float inv = 1.0f / l;
            bf16_t* op = O + trow * D + hq * 64 + 4 * hi;
#pragma unroll
            for (int i = 0; i < 4; ++i) {
                u32x2 w; w.x = pk2(o0[4 * i] * inv, o0[4 * i + 1] * inv); w.y = pk2(o0[4 * i + 2] * inv, o0[4 * i + 3] * inv);
                *(u32x2*)(op + 8 * i) = w;
                w.x = pk2(o1[4 * i] * inv, o1[4 * i + 1] * inv); w.y = pk2(o1[4 * i + 2] * inv, o1[4 * i + 3] * inv);
                *(u32x2*)(op + 32 + 8 * i) = w;
            }
        }
    }
}

struct Args { In in; float* out; unsigned char* ws; int ph_lo, ph_hi, li, pad; };

__global__ void __launch_bounds__(512, 2) mk_fwd(Args args) {
    extern __shared__ __attribute__((aligned(16))) unsigned char lds_raw[];
    Ctx c; c.lds = (LAS unsigned char*)lds_raw;
    c.tid = threadIdx.x; c.lane = c.tid & 63; c.wave = __builtin_amdgcn_readfirstlane(c.tid >> 6);
    c.G = gridDim.x; { const int bx = blockIdx.x; c.v = (c.G % 8 == 0) ? (bx % 8) * (c.G / 8) + bx / 8 : bx; }
    unsigned char* ws = args.ws;
    for (int u = c.tid; u < (LDS_BYTES - LDSCTL_OFF) / 4; u += 512) ((LAS unsigned*)(c.lds + LDSCTL_OFF))[u] = 0u;
    __syncthreads();
    if (c.tid == 0) {
        LAS unsigned long long* pt = (LAS unsigned long long*)(c.lds + LDSCTL_OFF + LC_PTRS);
#define PT(i) pt[i] = (unsigned long long)args.in.p[i];
        PT(0) PT(1) PT(2) PT(3) PT(4) PT(5) PT(6) PT(7) PT(8) PT(9) PT(10) PT(11) PT(12) PT(13) PT(14) PT(15) PT(16)
#undef PT
        pt[17] = (unsigned long long)args.out;
    }
    if (MK_N_LAUNCHES == 1) (void)xcd_barrier_post((unsigned*)(ws + WS_CTL) + CW_BAR, (volatile LAS unsigned*)(c.lds + LDSCTL_OFF + LC_BARST));
    __syncthreads();
    const int lo = args.ph_lo, hi = args.ph_hi;
#ifndef PHMASK
#define PHMASK 0xFFFF
#endif
#define IN(k) (((PHMASK >> ((k) > 10 ? (k) - 8 : (k))) & 1) && lo <= (k) && (k) < hi)
#define SEAM(k) do { if (IN(k) && IN((k) + 1)) { XcdBarrier bar_; bar_.bar = (unsigned*)(ws + WS_CTL) + CW_BAR; bar_.x = xb_xcc_id(); bar_.st = (volatile LAS unsigned*)(c.lds + LDSCTL_OFF + LC_BARST); xcd_barrier(bar_); } } while (0)
#define GBAR() do { XcdBarrier bar_; bar_.bar = (unsigned*)(ws + WS_CTL) + CW_BAR; bar_.x = xb_xcc_id(); bar_.st = (volatile LAS unsigned*)(c.lds + LDSCTL_OFF + LC_BARST); xcd_barrier(bar_); } while (0)
#ifndef DUPMASK
#define DUPMASK 0
#endif
#define RUNPH(k, ...) do { if (IN(k)) { __VA_ARGS__ if ((DUPMASK >> (k)) & 1) { GBAR(); __VA_ARGS__ } } } while (0)
#define XOUT ((float*)inptr(c, 17))
#define XRES ((bf16_t*)(ws + WS_XB))
#define WSP(T_, off) ((T_*)(ws + (off)))
    const LAS int* tile_e = (const LAS int*)(c.lds + LDSCTL_OFF + LC_TILEE); const LAS int* ntl = (const LAS int*)(c.lds + LDSCTL_OFF + LC_NT);

    RUNPH(0, { p0_prologue(c, ws); });
    SEAM(0);
    RUNPH(1, {
        fft1_phase(c, WSP(bf16_t, WS_HT), WSP(float, WS_TW), WSP(bf16_t, WS_Y2));
        GBAR();
        fft2_phase(c, WSP(bf16_t, WS_Y2), WSP(bf16_t, WS_UB), WSP(bf16_t, WS_VB), WSP(bf16_t, WS_U2048));
    });
    SEAM(1);
    RUNPH(2, {
        {
            SchedRows<4> S{(const char*)(ws + WS_UB), (const char*)(ws + WS_WP), D, 256, c.G, c.v};
            EpiF32 E{WSP(bf16_t, WS_PU)};
            pg8::gemm_phase<EpiF32, SchedRows<4>, true>(c.lds, D, S, E);
        }
        asm volatile("s_waitcnt vmcnt(0)" ::: "memory"); __syncthreads();
        {
            SchedRows<4> S{(const char*)(ws + WS_VB), (const char*)(ws + WS_WP) + (size_t)D * D * 2, D, 256, c.G, c.v};
            EpiMirror E{inptr(c, 0), XRES, inptr(c, 4), WSP(bf16_t, WS_PU)};
            pg8::gemm_phase<EpiMirror, SchedRows<4>, true>(c.lds, D, S, E);
        }
        {
            const Ctx cc = refresh(c);
            const bf16_t* U2 = WSP(bf16_t, WS_U2048); const bf16_t* Wc = WSP(bf16_t, WS_WP); const float* xin = inptr(c, 0); const float* bo = inptr(c, 4); bf16_t* Xo = XRES;
            for (int it = cc.v * 8 + cc.wave; it < BATCH * D; it += cc.G * 8) {
                const int bat = it >> 10, n = it & 1023;
                const u32x4 uu0 = *((const u32x4*)(U2 + (size_t)bat * D) + cc.lane), uu1 = *((const u32x4*)(U2 + (size_t)bat * D) + 64 + cc.lane);
                const u32x4 ww0 = *((const u32x4*)(Wc + (size_t)n * D) + cc.lane), ww1 = *((const u32x4*)(Wc + (size_t)n * D) + 64 + cc.lane);
                float a = bflo(uu0.x) * bflo(ww0.x) + bfhi(uu0.x) * bfhi(ww0.x) + bflo(uu0.y) * bflo(ww0.y) + bfhi(uu0.y) * bfhi(ww0.y) + bflo(uu0.z) * bflo(ww0.z) + bfhi(uu0.z) * bfhi(ww0.z) + bflo(uu0.w) * bflo(ww0.w) + bfhi(uu0.w) * bfhi(ww0.w);
                a += bflo(uu1.x) * bflo(ww1.x) + bfhi(uu1.x) * bfhi(ww1.x) + bflo(uu1.y) * bflo(ww1.y) + bfhi(uu1.y) * bfhi(ww1.y) + bflo(uu1.z) * bflo(ww1.z) + bfhi(uu1.z) * bfhi(ww1.z) + bflo(uu1.w) * bflo(ww1.w) + bfhi(uu1.w) * bfhi(ww1.w);
                a = wave_sum(a);
                if (cc.lane == 0) { const size_t o = ((size_t)bat * SEQ + 2048) * D + n; Xo[o] = (bf16_t)f2bf(xin[o] + a + bo[n]); }
            }
        }
    });
    SEAM(2);
#undef CNT
#define CNT ((unsigned*)(ws + WS_CTL) + CW_CNT + 64 * 0)
    if (IN(3)) router_phase<F8L0>(c, XRES, inptr(c, 2) + 0 * D, inptr(c, 10) + (size_t)0 * D * NE, inptr(c, 11) + 0 * NE, WSP(unsigned char, WS_HN8), WSP(int, WS_IDX), WSP(float, WS_GATE), WSP(int, WS_RANK), CNT, WSP(int, WS_BBASE), WSP(int, WS_XS));
    SEAM(3);
    RUNPH(3 + 1, { scatter_phase(c, CNT, WSP(int, WS_IDX), WSP(int, WS_RANK), WSP(int, WS_BBASE), WSP(int, WS_SLOTOF), WSP(int, WS_XS)); });
    SEAM(3 + 1);
    RUNPH(3 + 2, {
        moe_plan(c, CNT);
        typedef SchedMoEG<8, 2048, 128, F8L0 ? 1024 : 2048> SM;
        SM S{(const char*)(ws + WS_HN8), (const char*)(ws + WS_WGU + (size_t)0 * 128 * MiB), tile_e, WSP(int, WS_XS), __builtin_amdgcn_readfirstlane(ntl[0]), c.G, c.v};
        EpiGLU<F8L0> E{WSP(unsigned char, WS_HID), inptr(c, 13) + (size_t)0 * NE * 2048};
#ifdef PROBE_ABL
        pg8::gemm_phase<EpiGLU<F8L0>, SM, true, F8L0, PROBE_ABL, true>(c.lds, F8L0 ? D / 2 : D, S, E); GBAR();
#endif
        pg8::gemm_phase<EpiGLU<F8L0>, SM, true, F8L0, 0, true>(c.lds, F8L0 ? D / 2 : D, S, E);
    });
    SEAM(3 + 2);
    RUNPH(3 + 3, {
        moe_plan(c, CNT);
        typedef SchedMoE<4, 1024, 256, true, F8L0 ? 1024 : 2048> SM;
        SM S{(const char*)(ws + WS_HID), (const char*)(ws + WS_WD + (size_t)0 * 64 * MiB), tile_e, __builtin_amdgcn_readfirstlane(ntl[0]), c.G, c.v};
        EpiBf16<1, D, F8L0, true> E{WSP(bf16_t, WS_Y), inptr(c, 15) + (size_t)0 * NE * D};
        pg8::gemm_phase<EpiBf16<1, D, F8L0, true>, SM, true, F8L0, 0, false, F8L0>(c.lds, F8L0 ? D / 2 : D, S, E);
    });
    SEAM(3 + 3);
    if (IN(7)) combine_phase<false>(c, XRES, WSP(bf16_t, WS_Y), WSP(float, WS_GATE), WSP(int, WS_SLOTOF), inptr(c, 1) + D, WSP(bf16_t, WS_HN), nullptr);
    SEAM(7);
    RUNPH(8, {
#ifndef NO_QK
        {
            SchedRows<5> S{(const char*)(ws + WS_HN), (const char*)(ws + WS_WQKV), D, 640, c.G, c.v};
            EpiQK E{WSP(bf16_t, WS_Q), WSP(bf16_t, WS_K), inptr(c, 6), WSP(float, WS_COS)};
            pg8::gemm_phase<EpiQK, SchedRows<5>, true>(c.lds, D, S, E);
        }
#endif
#ifndef NO_VT
        {
            SchedVT S{(const char*)(ws + WS_WQKV) + (size_t)1280 * D * 2, (const char*)(ws + WS_HN), c.G, c.v, 128};
            EpiBf16<2, T> E{WSP(bf16_t, WS_VT), inptr(c, 6)};
            pg8::gemm_phase<EpiBf16<2, T>, SchedVT, true>(c.lds, D, S, E);
        }
#endif
    });
    SEAM(8);
    RUNPH(9, { attn_phase(c, WSP(bf16_t, WS_Q), WSP(bf16_t, WS_K), WSP(bf16_t, WS_VT), inptr(c, 7), WSP(bf16_t, WS_O)); });
    SEAM(9);
    if (IN(10)) {
        SchedRows<4> S{(const char*)(ws + WS_O), (const char*)(ws + WS_WO), D, 512, c.G, c.v};
        EpiX E{XRES, XRES, inptr(c, 9)};
        pg8::gemm_phase<EpiX, SchedRows<4>, true>(c.lds, D, S, E);
    }
    SEAM(10);
#undef CNT
#define CNT ((unsigned*)(ws + WS_CTL) + CW_CNT + 64 * 1)
    if (IN(11)) router_phase<F8L1>(c, XRES, inptr(c, 2) + 1 * D, inptr(c, 10) + (size_t)1 * D * NE, inptr(c, 11) + 1 * NE, WSP(unsigned char, WS_HN8), WSP(int, WS_IDX), WSP(float, WS_GATE), WSP(int, WS_RANK), CNT, WSP(int, WS_BBASE), WSP(int, WS_XS));
    SEAM(11);
    RUNPH(11 + 1, { scatter_phase(c, CNT, WSP(int, WS_IDX), WSP(int, WS_RANK), WSP(int, WS_BBASE), WSP(int, WS_SLOTOF), WSP(int, WS_XS)); });
    SEAM(11 + 1);
    RUNPH(11 + 2, {
        moe_plan(c, CNT);
        typedef SchedMoEG<8, 2048, 128, F8L1 ? 1024 : 2048> SM;
        SM S{(const char*)(ws + WS_HN8), (const char*)(ws + WS_WGU + (size_t)1 * 128 * MiB), tile_e, WSP(int, WS_XS), __builtin_amdgcn_readfirstlane(ntl[0]), c.G, c.v};
        EpiGLU<F8L1> E{WSP(unsigned char, WS_HID), inptr(c, 13) + (size_t)1 * NE * 2048};
        pg8::gemm_phase<EpiGLU<F8L1>, SM, true, F8L1, 0, true>(c.lds, F8L1 ? D / 2 : D, S, E);
    });
    SEAM(11 + 2);
    RUNPH(11 + 3, {
        moe_plan(c, CNT);
        typedef SchedMoE<4, 1024, 256, true, F8L1 ? 1024 : 2048> SM;
        SM S{(const char*)(ws + WS_HID), (const char*)(ws + WS_WD + (size_t)1 * 64 * MiB), tile_e, __builtin_amdgcn_readfirstlane(ntl[0]), c.G, c.v};
        EpiBf16<1, D, F8L1, true> E{WSP(bf16_t, WS_Y), inptr(c, 15) + (size_t)1 * NE * D};
        pg8::gemm_phase<EpiBf16<1, D, F8L1, true>, SM, true, F8L1, 0, false, F8L1>(c.lds, F8L1 ? D / 2 : D, S, E);
    });
    SEAM(11 + 3);
    if (IN(15)) combine_phase<true>(c, XRES, WSP(bf16_t, WS_Y), WSP(float, WS_GATE), WSP(int, WS_SLOTOF), inptr(c, 16), nullptr, XOUT);
#undef IN
#undef SEAM
}

extern "C" void kernel_launch(void* const* d_in, const int* in_sizes, int n_in, void* d_out, int out_size, void* d_ws, size_t ws_size, hipStream_t stream) {
    static int grid = 0;
    if (grid == 0) {
        if (n_in != 17 || out_size != T * D || ws_size < WS_END) { fprintf(stderr, "kernel_launch: unexpected sizes n_in %d out %d ws %zu (need %zu)\n", n_in, out_size, ws_size, (size_t)WS_END); grid = -1; return; }
        int dev = 0, cus = 0, per_cu = 0;
        if (hipGetDevice(&dev) != hipSuccess || hipDeviceGetAttribute(&cus, hipDeviceAttributeMultiprocessorCount, dev) != hipSuccess) { grid = -1; return; }
        if (hipFuncSetAttribute((const void*)mk_fwd, hipFuncAttributeMaxDynamicSharedMemorySize, LDS_BYTES) != hipSuccess) { fprintf(stderr, "kernel_launch: hipFuncSetAttribute failed\n"); grid = -1; return; }
        if (hipOccupancyMaxActiveBlocksPerMultiprocessor(&per_cu, (const void*)mk_fwd, 512, LDS_BYTES) != hipSuccess || per_cu < 1) { fprintf(stderr, "kernel_launch: occupancy query says %d blocks/CU\n", per_cu); grid = -1; return; }
        (void)hipGetLastError();
        grid = cus;
    }
    if (grid < 0) return;
    (void)hipMemsetAsync((char*)d_ws + WS_CTL, 0, CTL_ZERO_BYTES, stream);
    Args a{};
    for (int i = 0; i < 17; ++i) a.in.p[i] = (const float*)d_in[i];
    a.out = (float*)d_out; a.ws = (unsigned char*)d_ws;
    if (MK_N_LAUNCHES == 1) {
        a.ph_lo = 0; a.ph_hi = NPHASE; a.li = 0;
        hipLaunchKernelGGL(mk_fwd, dim3(grid), dim3(512), LDS_BYTES, stream, a);
    } else {
        for (int li = 0; li < NPHASE; ++li) { a.ph_lo = li; a.ph_hi = li + 1; a.li = li; hipLaunchKernelGGL(mk_fwd, dim3(grid), dim3(512), LDS_BYTES, stream, a); }
    }
}
```

```cpp
#include <hip/hip_runtime.h>
#include <cstdio>
#include <cstdint>

#ifndef ST_BITS
#define ST_BITS "sc0"
#endif
#define LAS __attribute__((address_space(3)))
#define DEVI __device__ __forceinline__
typedef unsigned short bf16_t;
typedef short bf16x8 __attribute__((ext_vector_type(8)));
typedef short s16x4 __attribute__((ext_vector_type(4)));
typedef float f32x2 __attribute__((ext_vector_type(2)));
typedef float f32x4 __attribute__((ext_vector_type(4)));
typedef float f32x16 __attribute__((ext_vector_type(16)));
typedef unsigned u32x2 __attribute__((ext_vector_type(2)));
typedef unsigned u32x4 __attribute__((ext_vector_type(4)));
typedef int i32x4 __attribute__((ext_vector_type(4)));
typedef int i32x8 __attribute__((ext_vector_type(8)));
typedef __bf16 bf16x2_t __attribute__((ext_vector_type(2)));

#define PG8_BUILTIN_DMA 0
#ifndef MK_N_LAUNCHES
#define MK_N_LAUNCHES 1
#endif
constexpr int NPHASE = 16;

constexpr int D = 1024, BATCH = 8, SEQ = 4096, T = BATCH * SEQ, NE = 32, TOPK = 4, QKVD = 1536, NH = 16;
constexpr int MT = 256, NSLOT = T * TOPK + NE * MT, NTILE = NSLOT / MT;
constexpr float RMS_EPS = 1e-5f;

constexpr size_t MiB = 1u << 20;
constexpr size_t WS_CTL = 0, CTL_ZERO_BYTES = 128 * 1024;
constexpr size_t WS_WGU = 2 * MiB;
constexpr size_t WS_WD = WS_WGU + 256 * MiB;
constexpr size_t WS_WP = WS_WD + 128 * MiB;
constexpr size_t WS_WQKV = WS_WP + 4 * MiB;
constexpr size_t WS_WO = WS_WQKV + 3 * MiB;
constexpr size_t WS_CS = WS_WO + 3 * MiB;
constexpr size_t WS_XB = WS_CS;
constexpr size_t WS_HT = WS_CS + 64 * MiB;
constexpr size_t WS_A2 = WS_HT + 64 * MiB;
constexpr size_t WS_UB = WS_A2, WS_VB = WS_A2 + 32 * MiB, WS_U2048 = WS_A2 + 64 * MiB;
constexpr size_t WS_HN = WS_A2 + 128 * MiB;
constexpr size_t WS_HN8 = WS_HN + 64 * MiB;
constexpr size_t WS_XS = WS_HN8 + 64 * MiB;
constexpr size_t WS_HID = WS_XS + 272 * MiB;
constexpr size_t WS_Y = WS_HID + 272 * MiB;
constexpr size_t WS_Q = WS_Y + 272 * MiB;
constexpr size_t WS_K = WS_Q + 64 * MiB;
constexpr size_t WS_VT = WS_K + 16 * MiB;
constexpr size_t WS_O = WS_VT + 16 * MiB;
constexpr size_t WS_IDX = WS_O + 64 * MiB;
constexpr size_t WS_GATE = WS_IDX + 1 * MiB;
constexpr size_t WS_RANK = WS_GATE + 1 * MiB;
constexpr size_t WS_SLOTOF = WS_RANK + 1 * MiB;
constexpr size_t WS_BBASE = WS_SLOTOF + 1 * MiB;
constexpr size_t WS_COS = WS_BBASE + 1 * MiB;
constexpr size_t WS_SIN = WS_COS + 1 * MiB;
constexpr size_t WS_TW = WS_SIN + 512 * 1024;
constexpr size_t WS_RS = WS_TW + 64 * 1024;
constexpr size_t WS_PU = WS_Y + 128 * MiB;
constexpr size_t WS_Y2 = WS_Y;
constexpr size_t WS_END = WS_SIN + 1 * MiB;
constexpr bool F8L0 = true, F8L1 = true;
constexpr float WSCALE = 32.0f, WINV = 1.0f / 32.0f;
constexpr int CW_BAR = 4096, CW_CNT = 16384;

constexpr int RING_BYTES = 131072;
constexpr int LDSCTL_OFF = 135168;
constexpr int LC_BARST = 0;
constexpr int LC_HIST = 64;
constexpr int LC_PST = 256;
constexpr int LC_NT = 384;
constexpr int LC_PTRS = 512;
constexpr int LC_PRE = 6144;
constexpr int LC_GTOK = 8192;
constexpr int LC_TILEE = 1024;
constexpr int LDS_BYTES = 147456;
static_assert(LDSCTL_OFF + LC_TILEE + NTILE * 4 <= LDS_BYTES, "LDS map");

#define RLX_AGENT __ATOMIC_RELAXED, __HIP_MEMORY_SCOPE_AGENT
DEVI unsigned f2bf(float f) { unsigned u = __builtin_bit_cast(unsigned, f); return (u + 0x7fffu + ((u >> 16) & 1u)) >> 16; }
DEVI unsigned pk2(float lo, float hi) { f32x2 v = {lo, hi}; bf16x2_t b = __builtin_convertvector(v, bf16x2_t); return __builtin_bit_cast(unsigned, b); }
DEVI unsigned pk4f8(float a, float b, float c, float d) { int w = 0; w = __builtin_amdgcn_cvt_pk_fp8_f32(a, b, w, false); w = __builtin_amdgcn_cvt_pk_fp8_f32(c, d, w, true); return (unsigned)w; }
DEVI float bflo(unsigned w) { return __builtin_bit_cast(float, w << 16); }
DEVI float bfhi(unsigned w) { return __builtin_bit_cast(float, w & 0xffff0000u); }
DEVI int opaque_tid();
template <int O> DEVI unsigned xor_u32(unsigned v, bool) {
    if constexpr (O < 32) return (unsigned)__builtin_amdgcn_ds_swizzle((int)v, (O << 10) | 0x1F);
    else return (unsigned)__builtin_amdgcn_ds_bpermute(((opaque_tid() ^ 32) & 63) << 2, (int)v);
}
template <int O> DEVI float xor_f32(float v, bool hi32) { return __builtin_bit_cast(float, xor_u32<O>(__builtin_bit_cast(unsigned, v), hi32)); }
DEVI float sum32(float v) { return v + xor_f32<32>(v, false); }
DEVI float max32(float v) { return fmaxf(v, xor_f32<32>(v, false)); }
DEVI float wave_sum(float v) {
    v += xor_f32<1>(v, false); v += xor_f32<2>(v, false); v += xor_f32<4>(v, false); v += xor_f32<8>(v, false); v += xor_f32<16>(v, false);
    return sum32(v);
}
DEVI int opaque_tid() { int t = threadIdx.x; asm volatile("" : "+v"(t)); return t; }

namespace pg8 {
constexpr int BM = 256, BK = 64, HALF = 128, HTB = HALF * BK * 2, STAGE_BYTES = 8 * HTB;
DEVI int lds_byte(int r, int c) { const int st = (r >> 4) * 2 + (c >> 5), rr = r & 15, cc = c & 31, ob = rr * 64 + cc * 2; return st * 1024 + (ob ^ (((ob >> 9) & 1) << 5)); }
DEVI void stage_rc(int b, int& R, int& C) { const int st = b / 1024, sb = b % 1024, swz = sb ^ (((sb >> 9) & 1) << 5); R = (st >> 1) * 16 + swz / 64; C = (st & 1) * 32 + (swz % 64) / 2; }
DEVI int perm32(int rho) { const int n = rho >> 4, i = rho & 15; return 8 * (i >> 2) + 4 * n + (i & 3); }

struct Unit { const char* a; const char* b; int orow, ocol, aux; };

template <class Epi, class Sched, bool ALIGN_EPI, bool FP8 = false, int ABL = 0  , bool GATHER = false>
DEVI void gemm_phase(LAS unsigned char* lds, const int K, const Sched& S, const Epi& E) {
    const int tid = opaque_tid(), wid = __builtin_amdgcn_readfirstlane(tid >> 6), lane = tid & 63, wr = wid >> 2, wc = wid & 3, fr = lane & 15, fq = lane >> 4;
    const int nt = K / BK;
    constexpr int PM = (int)Epi::PERM;
    unsigned voffA[2], voffB[2], gRC[2];
#pragma unroll
    for (int i = 0; i < 2; ++i) { int R, C; stage_rc(tid * 16 + i * 8192, R, C); const int Rb = PM == 2 ? (64 * (R >> 5) + 16 * ((R >> 2) & 3) + 4 * ((R >> 4) & 1) + (R & 3)) : PM == 1 ? ((R & ~31) + perm32(R & 31)) : R;
        voffA[i] = (unsigned)(R * K + C) * 2u; voffB[i] = (unsigned)(Rb * K + C) * 2u; gRC[i] = ((unsigned)R * 4u) | (((unsigned)C * 2u) << 16); }
    unsigned gvo[2] = {0u, 0u}, gnx[2] = {0u, 0u};
    const size_t kstep = (size_t)(BK * 2);
    const int rot = S.rot() & (nt - 1);
#define PG8_KO(lt) ((size_t)(((lt) + rot) & (nt - 1)) * kstep)
    const size_t hstep = (size_t)HALF * K * 2;
    const size_t hstepB = PM == 2 ? (size_t)8 * K * 2 : hstep;
    const unsigned ldsw = (unsigned)wid * 1024u;
    const unsigned ptabb = __builtin_amdgcn_readfirstlane((unsigned)(unsigned long long)lds) + (unsigned)(LDSCTL_OFF + LC_PRE);
    const unsigned gtab = __builtin_amdgcn_readfirstlane((unsigned)(unsigned long long)lds) + (unsigned)(LDSCTL_OFF + LC_GTOK);
    const unsigned ldsb = __builtin_amdgcn_readfirstlane((unsigned)(unsigned long long)lds) + ldsw;
    const int aoff = lds_byte(wr * 64 + fr, fq * 8), boff = lds_byte(wc * 32 + fr, fq * 8);
#define PG8_SA(b, h) (((b) * 2 + (h)) * HTB)
#define PG8_SB(b, h) ((4 + (b) * 2 + (h)) * HTB)
#if PG8_BUILTIN_DMA
#define PG8_STAGE(bufoff, gbase, voff) do { _Pragma("unroll") for (int _i = 0; _i < 2; ++_i) \
        __builtin_amdgcn_global_load_lds((const unsigned*)((const char*)(gbase) + (voff)[_i]), (LAS unsigned*)(lds + (bufoff) + ldsw + _i * 8192), 16, 0, 0); } while (0)
#else
#define PG8_STAGE(bufoff, gbase, voff) do { _Pragma("unroll") for (int _i = 0; _i < 2; ++_i) { unsigned keep_; \
        asm volatile("s_mov_b32 %0, m0\n\ts_mov_b32 m0, %3\n\ts_nop 0\n\tglobal_load_lds_dwordx4 %1, %2\n\ts_mov_b32 m0, %0" : "=&s"(keep_) : "v"((voff)[_i]), "s"((const char*)(gbase)), "s"(ldsb + (unsigned)((bufoff) + _i * 8192)) : "memory"); } } while (0)
#endif
#define PG8_GLOAD(bufi, u_) do { if constexpr (GATHER) { if (wid < 4) { unsigned keep_; \
        asm volatile("s_mov_b32 %0, m0\n\ts_mov_b32 m0, %3\n\ts_nop 0\n\tglobal_load_lds_dword %1, %2\n\ts_mov_b32 m0, %0" : "=&s"(keep_) \
            : "v"((unsigned)((u_).orow * 4) + (unsigned)((opaque_tid() & 255) * 4)), "s"((const char*)S.slot_tok), "s"(gtab + (unsigned)((bufi) * 1024) + (unsigned)(wid * 256)) : "memory"); } } } while (0)
#define PG8_GOFF(dst, h, bufsel) do { if constexpr (GATHER) { _Pragma("unroll") for (int _i = 0; _i < 2; ++_i) { \
        const unsigned tok_ = *(const LAS unsigned*)(lds + LDSCTL_OFF + LC_GTOK + ((bufsel) & 1) * 1024 + (h) * 512 + (gRC[_i] & 0xffffu)); dst[_i] = tok_ * (unsigned)(K * 2) + (gRC[_i] >> 16); } } } while (0)
#define PG8_GNEXT() do { if constexpr (GATHER) { gvo[0] = gnx[0]; gvo[1] = gnx[1]; } } while (0)
#define PG8_STAGE_A(bufoff, base, h) do { if constexpr (GATHER) { PG8_STAGE(bufoff, base, gvo); } else PG8_STAGE(bufoff, (base) + (h) * hstep, voffA); } while (0)
#define PG8_LDA(dst, b, h) do { _Pragma("unroll") for (int m = 0; m < 4; ++m) _Pragma("unroll") for (int k = 0; k < 2; ++k) dst[m][k] = *(const LAS bf16x8*)(lds + PG8_SA(b, h) + aoff + m * 2048 + k * 1024); } while (0)
#define PG8_LDB(dst, b, h) do { _Pragma("unroll") for (int n = 0; n < 2; ++n) _Pragma("unroll") for (int k = 0; k < 2; ++k) dst[n][k] = *(const LAS bf16x8*)(lds + PG8_SB(b, h) + boff + n * 2048 + k * 1024); } while (0)
#define PG8_CAT(x) __builtin_shufflevector(__builtin_bit_cast(i32x4, (x)[0]), __builtin_bit_cast(i32x4, (x)[1]), 0, 1, 2, 3, 4, 5, 6, 7)
#define PG8_MMA(ai, bj, At, Bt) do { if constexpr (ABL == 2) { asm volatile("" :: "v"(At[0][0]), "v"(At[3][1]), "v"(Bt[0][0]), "v"(Bt[1][1])); break; } __builtin_amdgcn_s_setprio(1); _Pragma("unroll") for (int m = 0; m < 4; ++m) _Pragma("unroll") for (int n = 0; n < 2; ++n) { \
        if constexpr (FP8) acc[ai][bj][m][n] = __builtin_amdgcn_mfma_scale_f32_16x16x128_f8f6f4(PG8_CAT(Bt[n]), PG8_CAT(At[m]), acc[ai][bj][m][n], 0, 0, 0, 0, 0, 0); \
        else { _Pragma("unroll") for (int k = 0; k < 2; ++k) acc[ai][bj][m][n] = __builtin_amdgcn_mfma_f32_16x16x32_bf16(Bt[n][k], At[m][k], acc[ai][bj][m][n], 0, 0, 0); } } __builtin_amdgcn_s_setprio(0); } while (0)
#define PG8_WAIT_V(n) asm volatile("s_waitcnt vmcnt(" #n ")" ::: "memory")
#define PG8_WAIT_L(n) asm volatile("s_waitcnt lgkmcnt(" #n ")" ::: "memory")
#define PG8_BAR __builtin_amdgcn_s_barrier()
#define PG8_SCHED __builtin_amdgcn_sched_barrier(0)
    Unit cur, nxt; int ui = 0;
    if (!S.next(0, cur)) return;
    f32x4 acc[2][2][4][2];
#pragma unroll
    for (int a = 0; a < 2; ++a)
#pragma unroll
        for (int b = 0; b < 2; ++b)
#pragma unroll
            for (int m = 0; m < 4; ++m)
#pragma unroll
                for (int n = 0; n < 2; ++n) acc[a][b][m][n] = (f32x4){0.f, 0.f, 0.f, 0.f};
    bf16x8 At[4][2], B0[2][2], B1[2][2];
    const char* cA = cur.a; const char* cB = cur.b;
    if constexpr (GATHER) { PG8_GLOAD(0, cur); asm volatile("s_waitcnt vmcnt(0)" ::: "memory"); __builtin_amdgcn_s_barrier(); asm volatile("" ::: "memory"); }
    PG8_STAGE(PG8_SB(0, 0), cB + PG8_KO(0), voffB); PG8_STAGE(PG8_SB(0, 1), cB + hstepB + PG8_KO(0), voffB); PG8_GOFF(gvo, 0, 0); PG8_STAGE_A(PG8_SA(0, 0), cA + PG8_KO(0), 0); PG8_GOFF(gvo, 1, 0); PG8_STAGE_A(PG8_SA(0, 1), cA + PG8_KO(0), 1);
    if (wr == 1) PG8_BAR;
    PG8_WAIT_V(2); PG8_BAR;
    PG8_STAGE(PG8_SB(1, 0), cB + PG8_KO(1), voffB); PG8_GOFF(gvo, 0, 0); PG8_STAGE_A(PG8_SA(1, 0), cA + PG8_KO(1), 0); PG8_STAGE(PG8_SB(1, 1), cB + hstepB + PG8_KO(1), voffB);
    PG8_WAIT_V(6); PG8_BAR;
    for (;;) {
        const bool has_next = S.next(ui + 1, nxt);
        const char* nA = has_next ? nxt.a : cA; const char* nB = has_next ? nxt.b : cB;
        if (has_next) PG8_GLOAD((ui + 1) & 1, nxt);
        PG8_GOFF(gnx, 1, ui);
        if constexpr (Epi::PRE) { if (wid < 4) { unsigned keep_;
            asm volatile("s_mov_b32 %0, m0\n\ts_mov_b32 m0, %3\n\ts_nop 0\n\tglobal_load_lds_dword %1, %2\n\ts_mov_b32 m0, %0" : "=&s"(keep_)
                : "v"(E.pre_off(cur, (opaque_tid() & 255))), "s"(E.pre_base()), "s"(ptabb + (unsigned)((ui & 1) * 1024) + (unsigned)(wid * 256)) : "memory"); } }
#pragma unroll 1
        for (int t = 0; t < nt; t += 2) {
            const bool last = (t == nt - 2);
            const char* a1 = cA + PG8_KO(t + 1);
            const size_t ko2 = PG8_KO(last ? 0 : t + 2), ko3 = PG8_KO(last ? 1 : t + 3);
            const char* a2 = (last ? nA : cA) + ko2; const char* b2 = (last ? nB : cB) + ko2;
            const char* a3 = (last ? nA : cA) + ko3; const char* b3 = (last ? nB : cB) + ko3;
            const int nb_ = (last && has_next) ? ui + 1 : ui;
            PG8_GNEXT(); PG8_LDB(B0, 0, 0); PG8_LDB(B1, 0, 1); PG8_SCHED; PG8_LDA(At, 0, 0); PG8_GOFF(gnx, 0, nb_); PG8_STAGE_A(PG8_SA(1, 1), a1, 1);
            PG8_WAIT_V(8); PG8_WAIT_L(0); PG8_BAR; PG8_MMA(0, 0, At, B0); PG8_MMA(0, 1, At, B1); PG8_BAR; PG8_SCHED;
            PG8_GNEXT(); PG8_LDA(At, 0, 1); PG8_GOFF(gnx, 1, nb_); PG8_STAGE(PG8_SB(0, 0), b2, voffB); PG8_STAGE(PG8_SB(0, 1), b2 + hstepB, voffB); PG8_STAGE_A(PG8_SA(0, 0), a2, 0);
            PG8_WAIT_V(8); PG8_WAIT_L(0); PG8_BAR; PG8_MMA(1, 0, At, B0); PG8_MMA(1, 1, At, B1); PG8_BAR; PG8_SCHED;
            PG8_GNEXT(); PG8_LDB(B0, 1, 0); PG8_LDB(B1, 1, 1); PG8_SCHED; PG8_LDA(At, 1, 0); PG8_GOFF(gnx, 0, nb_); PG8_STAGE_A(PG8_SA(0, 1), a2, 1);
            PG8_WAIT_V(8); PG8_WAIT_L(0); PG8_BAR; PG8_MMA(0, 0, At, B0); PG8_MMA(0, 1, At, B1); PG8_BAR; PG8_SCHED;
            PG8_GNEXT(); PG8_LDA(At, 1, 1); if (!last) PG8_GOFF(gnx, 1, nb_); PG8_STAGE(PG8_SB(1, 0), b3, voffB); PG8_STAGE(PG8_SB(1, 1), b3 + hstepB, voffB); PG8_STAGE_A(PG8_SA(1, 0), a3, 0);
            PG8_WAIT_V(8); PG8_WAIT_L(0); PG8_BAR; PG8_MMA(1, 0, At, B0); PG8_MMA(1, 1, At, B1); PG8_BAR; PG8_SCHED;
        }
        if constexpr (ALIGN_EPI) { if (wr == 0) PG8_BAR; }
        if constexpr (ABL == 0) E(acc, cur, (const LAS float*)(lds + LDSCTL_OFF + LC_PRE + (ui & 1) * 1024)); else { _Pragma("unroll") for (int a_ = 0; a_ < 2; ++a_) _Pragma("unroll") for (int b_ = 0; b_ < 2; ++b_) _Pragma("unroll") for (int m_ = 0; m_ < 4; ++m_) _Pragma("unroll") for (int n_ = 0; n_ < 2; ++n_) asm volatile("" :: "v"(acc[a_][b_][m_][n_])); }
        if (!has_next) break;
#pragma unroll
        for (int a = 0; a < 2; ++a)
#pragma unroll
            for (int b = 0; b < 2; ++b)
#pragma unroll
                for (int m = 0; m < 4; ++m)
#pragma unroll
                    for (int n = 0; n < 2; ++n) acc[a][b][m][n] = (f32x4){0.f, 0.f, 0.f, 0.f};
        cur = nxt; cA = nA; cB = nB; ++ui;
        if constexpr (ALIGN_EPI) { if (wr == 1) PG8_BAR; }
    }
    PG8_WAIT_V(0);
    if constexpr (!ALIGN_EPI) { if (wr == 0) PG8_BAR; }
    PG8_BAR;
#undef PG8_KO
#undef PG8_SA
#undef PG8_SB
#undef PG8_STAGE
#undef PG8_STAGE_A
#undef PG8_GLOAD
#undef PG8_GOFF
#undef PG8_GNEXT
#undef PG8_LDA
#undef PG8_LDB
#undef PG8_MMA
#undef PG8_CAT
#undef PG8_WAIT_V
#undef PG8_WAIT_L
#undef PG8_BAR
#undef PG8_SCHED
}
}
using pg8::Unit;
typedef f32x4 Acc[2][2][4][2];

template <int BIAS  , int LDC, bool S32 = false  , bool O8 = false  , bool CSC = false  >
struct EpiBf16 {
    static constexpr int PERM = O8 ? 2 : 1;
    static constexpr bool PRE = (BIAS == 1);
    DEVI const char* pre_base() const { return (const char*)bias; }
    DEVI unsigned pre_off(const Unit& u, int f) const { const int q = f >> 4, i = f & 15; return (unsigned)(u.aux + (O8 ? (q >> 2) * 64 + (q & 3) * 16 + i : (q >> 2) * 32 + (q & 3) * 8 + (i & 7) + 128 * (i >> 3))) * 4u; }
    bf16_t* O; const float* bias; const float* csc;
    DEVI void operator()(const Acc& acc, const Unit& u, const LAS float* ptab) const {
        const int tid_ = opaque_tid(), wid_ = tid_ >> 6, wr = wid_ >> 2, wc = wid_ & 3, fr = tid_ & 15, fq = (tid_ & 63) >> 4;
        const int lc = wc * 32 + 8 * fq;
        f32x4 cs[2][2];
        if (CSC) {
#pragma unroll
            for (int bj = 0; bj < 2; ++bj)
#pragma unroll
                for (int n = 0; n < 2; ++n) cs[bj][n] = *(const f32x4*)(csc + u.ocol + lc + bj * 128 + 4 * n); }
        bf16_t* base = O + (size_t)(u.orow + wr * 64 + fr) * LDC + u.ocol + lc;
        const float* bp = bias + u.aux + (BIAS == 1 ? lc : wr * 64 + fr);
        f32x4 bc[2][2];
        if (BIAS == 1) { const LAS f32x4* tb = (const LAS f32x4*)(ptab + (wc * 4 + fq) * 16); bc[0][0] = tb[0]; bc[0][1] = tb[1]; bc[1][0] = tb[2]; bc[1][1] = tb[3]; }
#pragma unroll
        for (int ai = 0; ai < 2; ++ai)
#pragma unroll
            for (int m = 0; m < 4; ++m) {
                bf16_t* rowp = base + (size_t)(ai * 128 + m * 16) * LDC;
                float br = 0.f; if (BIAS == 2) br = bp[ai * 128 + m * 16];
                u32x4 w8;
#pragma unroll
                for (int bj = 0; bj < 2; ++bj) {
                    f32x4 v0 = acc[ai][bj][m][0], v1 = acc[ai][bj][m][1];
                    if (S32) { v0 *= WINV; v1 *= WINV; }
                    if (CSC) { v0 *= cs[bj][0]; v1 *= cs[bj][1]; }
                    if (BIAS == 1) { v0 += bc[bj][0]; v1 += bc[bj][1]; }
                    if (BIAS == 2) { v0 += br; v1 += br; }
                    if (O8) { w8[2 * bj] = pk4f8(v0[0], v0[1], v0[2], v0[3]); w8[2 * bj + 1] = pk4f8(v1[0], v1[1], v1[2], v1[3]); }
                    else { u32x4 w; w.x = pk2(v0[0], v0[1]); w.y = pk2(v0[2], v0[3]); w.z = pk2(v1[0], v1[1]); w.w = pk2(v1[2], v1[3]);
                    *(u32x4*)(rowp + bj * 128) = w; }
                }
                if (O8) { unsigned char* sp_ = (unsigned char*)O + ((size_t)(u.orow + wr * 64 + fr + ai * 128 + m * 16) * LDC + u.ocol + wc * 64 + 16 * fq); asm volatile("global_store_dwordx4 %0, %1, off " ST_BITS :: "v"(sp_), "v"(w8) : "memory"); }
                asm volatile("" ::: "memory");
            }
    }
};
struct EpiX {
    static constexpr bool PERM = true;
    static constexpr bool PRE = false;
    const bf16_t* R; bf16_t* X; const float* bias;
    DEVI void operator()(const Acc& acc, const Unit& u, const LAS float* ptab) const {
        const int tid_ = opaque_tid(), wid_ = tid_ >> 6, wr = wid_ >> 2, wc = wid_ & 3, fr = tid_ & 15, fq = (tid_ & 63) >> 4;
        const int col0 = u.ocol + wc * 32 + 8 * fq;
        f32x4 bv[2][2];
#pragma unroll
        for (int bj = 0; bj < 2; ++bj)
#pragma unroll
            for (int n = 0; n < 2; ++n) bv[bj][n] = *(const f32x4*)(bias + col0 + bj * 128 + n * 4);
        const size_t off0 = (size_t)(u.orow + wr * 64 + fr) * D + col0;
        u32x4 rc[2], rn[2];
#pragma unroll
        for (int bj = 0; bj < 2; ++bj) rc[bj] = *(const u32x4*)(R + off0 + bj * 128);
#pragma unroll
        for (int it = 0; it < 8; ++it) {
            const int ai = it >> 2, m = it & 3;
            const size_t off = off0 + (size_t)(ai * 128 + m * 16) * D;
            if (it < 7) { const size_t offn = off0 + (size_t)(((it + 1) >> 2) * 128 + ((it + 1) & 3) * 16) * D;
#pragma unroll
                for (int bj = 0; bj < 2; ++bj) rn[bj] = *(const u32x4*)(R + offn + bj * 128); }
#pragma unroll
            for (int bj = 0; bj < 2; ++bj) {
                const u32x4 rw = rc[bj];
                const f32x4 v0 = (f32x4){bflo(rw.x), bfhi(rw.x), bflo(rw.y), bfhi(rw.y)} + acc[ai][bj][m][0] + bv[bj][0], v1 = (f32x4){bflo(rw.z), bfhi(rw.z), bflo(rw.w), bfhi(rw.w)} + acc[ai][bj][m][1] + bv[bj][1];
                u32x4 w; w.x = pk2(v0[0], v0[1]); w.y = pk2(v0[2], v0[3]); w.z = pk2(v1[0], v1[1]); w.w = pk2(v1[2], v1[3]);
                *(u32x4*)(X + off + bj * 128) = w;
            }
#pragma unroll
            for (int bj = 0; bj < 2; ++bj) rc[bj] = rn[bj];
            asm volatile("" ::: "memory");
        }
    }
};
struct EpiF32 {
    static constexpr bool PERM = true;
    static constexpr bool PRE = false;
    bf16_t* C;
    DEVI void operator()(const Acc& acc, const Unit& u, const LAS float* ptab) const {
        const int tid_ = opaque_tid(), wid_ = tid_ >> 6, wr = wid_ >> 2, wc = wid_ & 3, fr = tid_ & 15, fq = (tid_ & 63) >> 4;
        bf16_t* base = C + (size_t)(u.orow + wr * 64 + fr) * D + u.ocol + wc * 32 + 8 * fq;
#pragma unroll
        for (int ai = 0; ai < 2; ++ai)
#pragma unroll
            for (int m = 0; m < 4; ++m)
#pragma unroll
                for (int bj = 0; bj < 2; ++bj) { const f32x4 v0 = acc[ai][bj][m][0], v1 = acc[ai][bj][m][1];
                    u32x4 w; w.x = pk2(v0[0], v0[1]); w.y = pk2(v0[2], v0[3]); w.z = pk2(v1[0], v1[1]); w.w = pk2(v1[2], v1[3]);
                    *(u32x4*)(base + (size_t)(ai * 128 + m * 16) * D + bj * 128) = w; }
    }
};
struct EpiMirror {
    static constexpr bool PERM = true;
    static constexpr bool PRE = false;
    const float* R; bf16_t* X; const float* bias; const bf16_t* PU;
    DEVI void operator()(const Acc& acc, const Unit& u, const LAS float* ptab) const {
        const int tid_ = opaque_tid(), wid_ = tid_ >> 6, wr = wid_ >> 2, wc = wid_ & 3, fr = tid_ & 15, fq = (tid_ & 63) >> 4;
        const int col0 = u.ocol + wc * 32 + 8 * fq;
        const int r0 = u.orow + wr * 64 + fr;
        const int bat = r0 >> 11, sp0 = r0 & 2047;
        const float* x1p = R + ((size_t)bat * SEQ + sp0) * D + col0; bf16_t* y1p = X + ((size_t)bat * SEQ + sp0) * D + col0;
        const bf16_t* pup = PU + (size_t)r0 * D + col0;
        f32x4 bv[2][2];
#pragma unroll
        for (int bj = 0; bj < 2; ++bj)
#pragma unroll
            for (int n = 0; n < 2; ++n) bv[bj][n] = *(const f32x4*)(bias + col0 + bj * 128 + n * 4);
        u32x4 pc, pn; f32x4 ac[2], bc2[2], an[2], bn[2];
#define EM_LOAD(P_, A_, B_, st_) { const int ro_ = ((st_) >> 3) * 128 + (((st_) >> 1) & 3) * 16, co_ = ((st_) & 1) * 128, spn_ = sp0 + ro_; \
        const float* x2p_ = R + ((size_t)bat * SEQ + ((SEQ - spn_) & (SEQ - 1))) * D + col0 + co_; \
        P_ = __builtin_nontemporal_load((const u32x4*)(pup + (size_t)ro_ * D + co_)); \
        _Pragma("unroll") for (int n = 0; n < 2; ++n) { A_[n] = *(const f32x4*)(x1p + (size_t)ro_ * D + co_ + n * 4); B_[n] = *(const f32x4*)(x2p_ + n * 4); } }
        EM_LOAD(pc, ac, bc2, 0)
#pragma unroll
        for (int st = 0; st < 16; ++st) {
            const int ai = st >> 3, m = (st >> 1) & 3, bj = st & 1, ro = ai * 128 + m * 16, co = bj * 128, sp = sp0 + ro;
            if (st < 15) EM_LOAD(pn, an, bn, st + 1)
            bf16_t* x2o = X + ((size_t)bat * SEQ + ((SEQ - sp) & (SEQ - 1))) * D + col0 + co;
            const f32x4 pu0 = (f32x4){bflo(pc.x), bfhi(pc.x), bflo(pc.y), bfhi(pc.y)} + bv[bj][0], pu1 = (f32x4){bflo(pc.z), bfhi(pc.z), bflo(pc.w), bfhi(pc.w)} + bv[bj][1];
            { const f32x4 o0 = ac[0] + pu0 + acc[ai][bj][m][0], o1 = ac[1] + pu1 + acc[ai][bj][m][1];
              u32x4 w; w.x = pk2(o0[0], o0[1]); w.y = pk2(o0[2], o0[3]); w.z = pk2(o1[0], o1[1]); w.w = pk2(o1[2], o1[3]); *(u32x4*)(y1p + (size_t)ro * D + co) = w; }
            if (sp != 0) { const f32x4 o0 = bc2[0] + pu0 - acc[ai][bj][m][0], o1 = bc2[1] + pu1 - acc[ai][bj][m][1];
              u32x4 w; w.x = pk2(o0[0], o0[1]); w.y = pk2(o0[2], o0[3]); w.z = pk2(o1[0], o1[1]); w.w = pk2(o1[2], o1[3]); *(u32x4*)x2o = w; }
            pc = pn;
#pragma unroll
            for (int n = 0; n < 2; ++n) { ac[n] = an[n]; bc2[n] = bn[n]; }
            asm volatile("" ::: "memory");
        }
#undef EM_LOAD
    }
};
template <bool F8>
struct EpiGLU {
    static constexpr bool PERM = true;
    static constexpr bool PRE = true;
    DEVI const char* pre_base() const { return (const char*)bgu; }
    DEVI unsigned pre_off(const Unit& u, int f) const { const int q = f >> 4, i = f & 15; return (unsigned)(u.aux * 2048 + u.ocol + (q >> 2) * 32 + (q & 3) * 8 + (i & 7) + 1024 * (i >> 3)) * 4u; }
    unsigned char* HID; const float* bgu;
    DEVI void operator()(const Acc& acc, const Unit& u, const LAS float* ptab) const {
        const int tid_ = opaque_tid(), wid_ = tid_ >> 6, wr = wid_ >> 2, wc = wid_ & 3, fr = tid_ & 15, fq = (tid_ & 63) >> 4;
        const int lc = wc * 32 + 8 * fq;
        const LAS f32x4* tb = (const LAS f32x4*)(ptab + (wc * 4 + fq) * 16);
        const f32x4 g0 = tb[0], g1 = tb[1], u0 = tb[2], u1 = tb[3];
        constexpr int EB = F8 ? 1 : 2; constexpr float SC = F8 ? WINV : 1.0f;
        unsigned char* base = HID + ((size_t)(u.orow + wr * 64 + fr) * D + u.ocol + lc) * EB;
#pragma unroll
        for (int ai = 0; ai < 2; ++ai)
#pragma unroll
            for (int m = 0; m < 4; ++m) {
                float o[8];
#pragma unroll
                for (int n = 0; n < 2; ++n)
#pragma unroll
                    for (int j = 0; j < 4; j += 2) {
                        const f32x4 bgv = n ? g1 : g0, buv = n ? u1 : u0;
                        f32x2 g = (f32x2){acc[ai][0][m][n][j], acc[ai][0][m][n][j + 1]} * SC + (f32x2){bgv[j], bgv[j + 1]};
                        f32x2 up = (f32x2){acc[ai][1][m][n][j], acc[ai][1][m][n][j + 1]} * SC + (f32x2){buv[j], buv[j + 1]};
                        g.x = fminf(g.x, 7.0f); g.y = fminf(g.y, 7.0f);
                        up.x = __builtin_amdgcn_fmed3f(up.x, -7.0f, 7.0f); up.y = __builtin_amdgcn_fmed3f(up.y, -7.0f, 7.0f);
                        f32x2 e = g * (-1.702f * 1.4426950408889634f);
                        e.x = __builtin_amdgcn_exp2f(e.x); e.y = __builtin_amdgcn_exp2f(e.y);
                        const f32x2 d = e + 1.0f;
                        f32x2 r; r.x = __builtin_amdgcn_rcpf(d.x); r.y = __builtin_amdgcn_rcpf(d.y);
                        const f32x2 glu = g * r, ov = up * glu + glu;
                        o[n * 4 + j] = ov.x; o[n * 4 + j + 1] = ov.y;
                    }
                unsigned char* dp = base + (size_t)(ai * 128 + m * 16) * D * EB;
                if (F8) { u32x2 w; w.x = pk4f8(o[0], o[1], o[2], o[3]); w.y = pk4f8(o[4], o[5], o[6], o[7]); asm volatile("global_store_dwordx2 %0, %1, off " ST_BITS :: "v"(dp), "v"(w) : "memory"); }
                else { u32x4 w; w.x = pk2(o[0], o[1]); w.y = pk2(o[2], o[3]); w.z = pk2(o[4], o[5]); w.w = pk2(o[6], o[7]); *(u32x4*)dp = w; }
                asm volatile("" ::: "memory");
            }
    }
};
struct EpiQK {
    static constexpr bool PERM = true;
    static constexpr bool PRE = false;
    bf16_t* Q; bf16_t* Kb; const float* bias; const float* cosT; const float* RS;
    DEVI void operator()(const Acc& acc, const Unit& u, const LAS float* ptab) const {
        const int tid_ = opaque_tid(), wid_ = tid_ >> 6, wr = wid_ >> 2, wc = wid_ & 3, fr = tid_ & 15, fq = (tid_ & 63) >> 4;
        const int pn = u.aux; const bool isq = pn < 4;
        bf16_t* base = isq ? Q + pn * 256 : Kb; const long ld = isq ? 1024 : 256; const float sc = isq ? 0.125f * 1.4426950408889634f : 1.0f;
        const int i0 = 8 * fq;
        const float* bp = bias + pn * 256 + wc * 64 + i0;
        bf16_t* rbase = base + (size_t)(u.orow + wr * 64 + fr) * ld + wc * 64 + i0;
        const int pos0 = (u.orow + wr * 64 + fr) & (SEQ - 1);
        const f32x4 bl0 = *(const f32x4*)bp, bl1 = *(const f32x4*)(bp + 4), bh0 = *(const f32x4*)(bp + 32), bh1 = *(const f32x4*)(bp + 36);
        const float* tp = cosT + pos0 * 32 + i0;
        f32x4 c0 = *(const f32x4*)tp, c1 = *(const f32x4*)(tp + 4), s0 = *(const f32x4*)(tp + 262144), s1 = *(const f32x4*)(tp + 262144 + 4), nc0, nc1, ns0, ns1;
        const float* rsp = RS + u.orow + wr * 64 + fr; float rc = rsp[0], rn = 0.f;
#pragma unroll
        for (int it = 0; it < 8; ++it) {
            const int ai = it >> 2, m = it & 3;
            if (it < 7) { const float* tn = tp + (((it + 1) >> 2) * 128 + ((it + 1) & 3) * 16) * 32;
                nc0 = *(const f32x4*)tn; nc1 = *(const f32x4*)(tn + 4); ns0 = *(const f32x4*)(tn + 262144); ns1 = *(const f32x4*)(tn + 262144 + 4); rn = rsp[((it + 1) >> 2) * 128 + ((it + 1) & 3) * 16]; }
            const f32x4 lo0 = acc[ai][0][m][0] * rc + bl0, lo1 = acc[ai][0][m][1] * rc + bl1, hi0 = acc[ai][1][m][0] * rc + bh0, hi1 = acc[ai][1][m][1] * rc + bh1;
            const f32x4 ol0 = (lo0 * c0 - hi0 * s0) * sc, ol1 = (lo1 * c1 - hi1 * s1) * sc;
            const f32x4 oh0 = (hi0 * c0 + lo0 * s0) * sc, oh1 = (hi1 * c1 + lo1 * s1) * sc;
            bf16_t* rowp = rbase + (size_t)(ai * 128 + m * 16) * ld;
            u32x4 w; w.x = pk2(ol0[0], ol0[1]); w.y = pk2(ol0[2], ol0[3]); w.z = pk2(ol1[0], ol1[1]); w.w = pk2(ol1[2], ol1[3]);
            *(u32x4*)rowp = w;
            w.x = pk2(oh0[0], oh0[1]); w.y = pk2(oh0[2], oh0[3]); w.z = pk2(oh1[0], oh1[1]); w.w = pk2(oh1[2], oh1[3]);
            *(u32x4*)(rowp + 32) = w;
            c0 = nc0; c1 = nc1; s0 = ns0; s1 = ns1; rc = rn;
            asm volatile("" ::: "memory");
        }
    }
};

struct SchedDFT {
    const char* CS; const char* HT; int G, v;
    DEVI bool next(int i, Unit& u) const {
        const int L = i * G + v; if (L >= 1024) return false;
        const int b = L >> 7, j = L & 127, pm = (j >> 5) * 8 + (j & 7), pn = (j >> 3) & 3;
        u.a = CS + (size_t)pm * 256 * SEQ * 2; u.b = HT + ((size_t)b * D + pn * 256) * SEQ * 2;
        u.orow = b * SEQ + (pm & 15) * 256; u.ocol = (pm >> 4) * 1024 + pn * 256; u.aux = 0; return true;
    }
};
template <int NPN>
struct SchedRows {
    const char* A; const char* Bt; int K, nunits, G, v;
    DEVI int rot() const { return 0; }
    DEVI bool next(int i, Unit& u) const {
        const int L = i * G + v; if (L >= nunits) return false;
        const int grp = L / (8 * NPN), j = L % (8 * NPN), pm = grp * 8 + (j & 7), pn = j >> 3;
        u.a = A + (size_t)pm * 256 * K * 2; u.b = Bt + (size_t)pn * 256 * K * 2;
        u.orow = pm * 256; u.ocol = pn * 256; u.aux = pn; return true;
    }
};
struct SchedVT {
    const char* Wv; const char* HN; int G, v, v0;
    DEVI int rot() const { return 0; }
    DEVI bool next(int i, Unit& u) const {
        const int L = i * G + v - v0; if (L < 0 || L >= T / 256) return false;
        u.a = Wv; u.b = HN + (size_t)L * 256 * D * 2; u.orow = 0; u.ocol = L * 256; u.aux = 1280; return true;
    }
};
template <int NPN> DEVI bool moe_unit(int i, int G, int v, int ntiles, int& tr, int& pn) {
    if ((G & 7) == 0) {
        const int P = G >> 3, x = v / P, j = v - x * P, r0 = (x * ntiles) >> 3, r1 = ((x + 1) * ntiles) >> 3, q = i * P + j;
        tr = r0 + q / NPN; pn = q % NPN; return tr < r1;
    }
    const int L = i * G + v; tr = L / NPN; pn = L % NPN; return L < ntiles * NPN;
}
template <int NPN> DEVI int moe_rot(int G, int v) {
    if ((G & 7) != 0) return 0;
    const int P = G >> 3, j = v % P, pn = j % NPN, tl = j / NPN;
    return NPN == 8 ? (pn + 2 * tl) & 7 : (2 * pn + tl) & 7;
}
template <int NPN, int WROWS, int OCW, bool AUXB, int RB  >
struct SchedMoE {
    const char* A; const char* W; const LAS int* tile_e; int ntiles, G, v;
    DEVI int rot() const { return moe_rot<NPN>(G, v); }
    DEVI bool next(int i, Unit& u) const {
        int tr, pn; if (!moe_unit<NPN>(i, G, v, ntiles, tr, pn)) return false;
        const int e = __builtin_amdgcn_readfirstlane(tile_e[tr]);
        u.a = A + (size_t)tr * 256 * RB; u.b = W + ((size_t)e * WROWS + pn * 256) * RB;
        u.orow = tr * 256; u.ocol = pn * OCW; u.aux = AUXB ? e * D + pn * OCW : e; return true;
    }
};

template <int NPN, int WROWS, int OCW, int RB>
struct SchedMoEG {
    const char* A; const char* W; const LAS int* tile_e; const int* slot_tok; int ntiles, G, v;
    DEVI int rot() const { return moe_rot<NPN>(G, v); }
    DEVI bool next(int i, Unit& u) const {
        int tr, pn; if (!moe_unit<NPN>(i, G, v, ntiles, tr, pn)) return false;
        const int e = __builtin_amdgcn_readfirstlane(tile_e[tr]);
        u.a = A; u.b = W + ((size_t)e * WROWS + pn * 256) * RB;
        u.orow = tr * 256; u.ocol = pn * OCW; u.aux = e; return true;
    }
};

#define XB_TMO      128
#define XB_XCNT(j)  (256  + 64 * (j))
#define XB_XSUB(j)  (1280 + 64 * (j))
#define XB_XGEN(j)  (2304 + 64 * (j))
#define XB_TOP      3328
#define XB_TOPGEN   3392
#define XCD_BAR_WORDS 3456
#define XB_SPIN_CAP (1u << 20)
DEVI unsigned xb_ld(unsigned* p)              { return __hip_atomic_load(p, RLX_AGENT); }
DEVI unsigned xb_add(unsigned* p, unsigned v) { return __hip_atomic_fetch_add(p, v, RLX_AGENT); }
DEVI unsigned xb_xcc_id() { return (unsigned)__builtin_amdgcn_s_getreg((3 << 11) | 20) & 0xFu; }
#define XB_SPIN(cond, bar) do { unsigned _sp = 0; while (cond) { __builtin_amdgcn_s_sleep(1); \
    if ((++_sp & 255u) == 0u) { if (xb_ld(&(bar)[XB_TMO])) break; if (_sp > XB_SPIN_CAP) { atomicAdd(&(bar)[XB_TMO], 1u); break; } } } } while (0)
struct XcdBarrier { unsigned* bar; unsigned x; volatile LAS unsigned* st; };
DEVI XcdBarrier xcd_barrier_post(unsigned* bar, volatile LAS unsigned* st) {
    XcdBarrier b; b.bar = bar; b.x = xb_xcc_id(); b.st = st;
    if (threadIdx.x == 0) (void)xb_add(&bar[XB_XCNT(b.x)], 1u);
    return b;
}
DEVI void xcd_barrier_complete(unsigned* bar, unsigned x, unsigned& nloc, unsigned& nx) {
    const unsigned G = gridDim.x * gridDim.y * gridDim.z;
    unsigned sum, cnt, mine, sp = 0u;
    for (;;) {
        sum = 0u; cnt = 0u; mine = 0u;
#pragma unroll
        for (unsigned j = 0; j < 16; ++j) { const unsigned c = xb_ld(&bar[XB_XCNT(j)]); sum += c; cnt += (c > 0u) ? 1u : 0u; mine = (j == x) ? c : mine; }
        if (sum == G) break;
        __builtin_amdgcn_s_sleep(1);
        if ((++sp & 255u) == 0u) { if (xb_ld(&bar[XB_TMO])) break; if (sp > XB_SPIN_CAP) { atomicAdd(&bar[XB_TMO], 1u); break; } }
    }
    nloc = mine > 0u ? mine : 1u; nx = cnt > 0u ? cnt : 1u;
}
DEVI void xcd_barrier(const XcdBarrier& b) {
    asm volatile("s_waitcnt vmcnt(0)" ::: "memory");
    __syncthreads();
    if (threadIdx.x == 0) {
        unsigned* bar = b.bar; asm volatile("" : "+s"(bar));
        __builtin_amdgcn_s_waitcnt(0);
        unsigned nloc = b.st[0], nx = b.st[1];
        if (nloc == 0u) { xcd_barrier_complete(bar, b.x, nloc, nx); b.st[0] = nloc; b.st[1] = nx; }
        const unsigned old = xb_add(&bar[XB_XSUB(b.x)], 1u);
        const unsigned gen = old / nloc;
        if (old + 1u == (gen + 1u) * nloc) {
            __builtin_amdgcn_fence(__ATOMIC_RELEASE, "agent");
            asm volatile("s_waitcnt vmcnt(0)" ::: "memory");
            const unsigned og = xb_add(&bar[XB_TOP], 1u);
            const unsigned tg = og / nx;
            if (og + 1u == (tg + 1u) * nx) xb_add(&bar[XB_TOPGEN], 1u);
            else XB_SPIN(xb_ld(&bar[XB_TOPGEN]) == tg, bar);
            __builtin_amdgcn_fence(__ATOMIC_ACQUIRE, "agent");
            xb_add(&bar[XB_XGEN(b.x)], 1u);
            asm volatile("s_waitcnt vmcnt(0)" ::: "memory");
        } else {
            XB_SPIN(xb_ld(&bar[XB_XGEN(b.x)]) == gen, bar);
            __builtin_amdgcn_fence(__ATOMIC_ACQUIRE, "agent");
            asm volatile("s_waitcnt vmcnt(0)" ::: "memory");
        }
    }
    __syncthreads();
}

struct Ctx { LAS unsigned char* lds; int tid, lane, wave, v, G; };
DEVI Ctx refresh(const Ctx& c0) { Ctx c = c0; c.tid = opaque_tid(); c.lane = c.tid & 63; return c; }

DEVI void transpose_item64_f8(const float* W, int ldw, int k0, int ca, int cb, unsigned char* dst, int K, int rho0, LAS float* scr, int lane) {
    const int r = lane >> 4, q = lane & 15, cs = (q < 8) ? ca + 4 * q : cb + 4 * (q - 8);
    const float* src = W + (size_t)(k0 + r) * ldw + cs;
    f32x4 v[16];
#pragma unroll
    for (int i = 0; i < 16; ++i) v[i] = *(const f32x4*)(src + (size_t)(4 * i) * ldw);
#pragma unroll
    for (int i = 0; i < 16; ++i) { LAS float* t = scr + (4 * i + r) * 65 + 4 * q; t[0] = v[i].x * WSCALE; t[1] = v[i].y * WSCALE; t[2] = v[i].z * WSCALE; t[3] = v[i].w * WSCALE; }
    asm volatile("s_waitcnt lgkmcnt(0)" ::: "memory");
    const int kc = lane & 3, nn = lane >> 2;
#pragma unroll
    for (int j = 0; j < 4; ++j) { const int n = nn + 16 * j; const LAS float* t = scr + (16 * kc) * 65 + n;
        u32x4 o; o.x = pk4f8(t[0 * 65], t[1 * 65], t[2 * 65], t[3 * 65]); o.y = pk4f8(t[4 * 65], t[5 * 65], t[6 * 65], t[7 * 65]);
        o.z = pk4f8(t[8 * 65], t[9 * 65], t[10 * 65], t[11 * 65]); o.w = pk4f8(t[12 * 65], t[13 * 65], t[14 * 65], t[15 * 65]);
        *(u32x4*)(dst + (size_t)(rho0 + n) * K + k0 + 16 * kc) = o; }
    asm volatile("s_waitcnt lgkmcnt(0)" ::: "memory");
}
DEVI void transpose_item64(const float* W, int ldw, int k0, int ca, int cb, bf16_t* dst, int K, int rho0, LAS float* scr, int lane) {
    const int r = lane >> 4, q = lane & 15, cs = (q < 8) ? ca + 4 * q : cb + 4 * (q - 8);
    const float* src = W + (size_t)(k0 + r) * ldw + cs;
    f32x4 v[16];
#pragma unroll
    for (int i = 0; i < 16; ++i) v[i] = *(const f32x4*)(src + (size_t)(4 * i) * ldw);
#pragma unroll
    for (int i = 0; i < 16; ++i) { LAS float* t = scr + (4 * i + r) * 65 + 4 * q; t[0] = v[i].x; t[1] = v[i].y; t[2] = v[i].z; t[3] = v[i].w; }
    asm volatile("s_waitcnt lgkmcnt(0)" ::: "memory");
    const int kc = lane & 7, nn = lane >> 3;
#pragma unroll
    for (int j = 0; j < 8; ++j) { const int n = nn + 8 * j; const LAS float* t = scr + (8 * kc) * 65 + n;
        u32x4 o; o.x = pk2(t[0 * 65], t[1 * 65]); o.y = pk2(t[2 * 65], t[3 * 65]); o.z = pk2(t[4 * 65], t[5 * 65]); o.w = pk2(t[6 * 65], t[7 * 65]);
        *(u32x4*)(dst + (size_t)(rho0 + n) * K + k0 + 8 * kc) = o; }
    asm volatile("s_waitcnt lgkmcnt(0)" ::: "memory");
}

struct TrItem { const float* src; size_t ldw4; unsigned char* dst; int k0, rho0; bool f8; const float* gsc; };
DEVI void tr_load(const TrItem& t, f32x4 (&v)[16]) {
#pragma unroll
    for (int i = 0; i < 16; ++i) v[i] = __builtin_nontemporal_load((const f32x4*)(t.src + (size_t)i * t.ldw4));
}
DEVI void tr_finish(const TrItem& t, const f32x4 (&v)[16], LAS float* scr, int lane) {
    if (t.f8) {
        const int r = lane >> 3, q = lane & 7;
#pragma unroll
        for (int i = 0; i < 16; ++i) { LAS float* p = scr + (8 * i + r) * 33 + 4 * q; p[0] = v[i].x * WSCALE; p[1] = v[i].y * WSCALE; p[2] = v[i].z * WSCALE; p[3] = v[i].w * WSCALE; }
        asm volatile("s_waitcnt lgkmcnt(0)" ::: "memory");
        const int kc = lane & 7, nn = lane >> 3;
#pragma unroll
        for (int j = 0; j < 4; ++j) { const int n = nn + 8 * j; const LAS float* p = scr + (16 * kc) * 33 + n;
            u32x4 o; o.x = pk4f8(p[0 * 33], p[1 * 33], p[2 * 33], p[3 * 33]); o.y = pk4f8(p[4 * 33], p[5 * 33], p[6 * 33], p[7 * 33]);
            o.z = pk4f8(p[8 * 33], p[9 * 33], p[10 * 33], p[11 * 33]); o.w = pk4f8(p[12 * 33], p[13 * 33], p[14 * 33], p[15 * 33]);
            *(u32x4*)(t.dst + (size_t)(t.rho0 + n) * D + t.k0 + 16 * kc) = o; }
    } else {
        const int r = lane >> 4, q = lane & 15;
#pragma unroll
        for (int i = 0; i < 16; ++i) { LAS float* p = scr + (4 * i + r) * 65 + 4 * q; const float gk = t.gsc ? t.gsc[t.k0 + 4 * i + r] : 1.0f; p[0] = v[i].x * gk; p[1] = v[i].y * gk; p[2] = v[i].z * gk; p[3] = v[i].w * gk; }
        asm volatile("s_waitcnt lgkmcnt(0)" ::: "memory");
        const int kc = lane & 7, nn = lane >> 3;
#pragma unroll
        for (int j = 0; j < 8; ++j) { const int n = nn + 8 * j; const LAS float* p = scr + (8 * kc) * 65 + n;
            u32x4 o; o.x = pk2(p[0 * 65], p[1 * 65]); o.y = pk2(p[2 * 65], p[3 * 65]); o.z = pk2(p[4 * 65], p[5 * 65]); o.w = pk2(p[6 * 65], p[7 * 65]);
            *(u32x4*)((bf16_t*)t.dst + (size_t)(t.rho0 + n) * D + t.k0 + 8 * kc) = o; }
    }
    asm volatile("s_waitcnt lgkmcnt(0)" ::: "memory");
}
struct In { const float* p[17]; };
DEVI const float* inptr(const Ctx& c, int i) {
    const LAS unsigned* q = (const LAS unsigned*)(c.lds + LDSCTL_OFF + LC_PTRS + 8 * i);
    const unsigned lo = __builtin_amdgcn_readfirstlane(q[0]), hi = __builtin_amdgcn_readfirstlane(q[1]);
    return (const float*)(((unsigned long long)hi << 32) | lo);
}

DEVI void p0_prologue(const Ctx& c0, unsigned char* ws) {
    const Ctx c = refresh(c0);
    const int gw = c.v * 8 + c.wave, NGW = c.G * 8;
    {
        LAS float* scr = (LAS float*)(c.lds + c.wave * 16896);
        constexpr int I_GU = 16 * 32, I_D = 16 * 16, N_GU = 64 * I_GU, N_D = 64 * I_D, I_QKV = 16 * 24, I_O = 16 * 16;
        constexpr int NIT = N_GU + N_D + I_QKV + I_O;
        const int lr = c.lane >> 4, lq = c.lane & 15;
        auto decode = [&](int it, TrItem& t) {
            int r = it; const float* W; int ldw, ca, cb;
            bool wide = false; t.gsc = nullptr;
            if (r < N_GU) {
                const int le = r / I_GU, q = r % I_GU; t.f8 = (le >> 5) ? F8L1 : F8L0; wide = t.f8;
                const int kb = wide ? (q >> 6) : (q >> 5), rb = wide ? (q & 63) : (q & 31), rho0 = wide ? rb * 32 : rb * 64;
                const int pn = rho0 >> 8, bj = (rho0 >> 7) & 1, i = rho0 & 127, c0 = bj * 1024 + pn * 128 + i;
                t.dst = ws + WS_WGU + (size_t)(le >> 5) * 128 * MiB + (size_t)(le & 31) * 2048 * D * (t.f8 ? 1 : 2);
                W = inptr(c, 12) + (size_t)le * D * 2048; ldw = 2048; ca = c0; cb = c0 + 32; t.k0 = kb * (wide ? 128 : 64); t.rho0 = rho0;
            } else if ((r -= N_GU) < N_D) {
                const int le = r / I_D, q = r % I_D; t.f8 = (le >> 5) ? F8L1 : F8L0; wide = t.f8;
                const int kb = wide ? (q >> 5) : (q >> 4), rb = wide ? (q & 31) : (q & 15), rho0 = wide ? rb * 32 : rb * 64;
                t.dst = ws + WS_WD + (size_t)(le >> 5) * 64 * MiB + (size_t)(le & 31) * D * D * (t.f8 ? 1 : 2);
                W = inptr(c, 14) + (size_t)le * D * D; ldw = D; ca = rho0; cb = ca + 32; t.k0 = kb * (wide ? 128 : 64); t.rho0 = rho0;
            } else if ((r -= N_D) < I_QKV) {
                const int kb = r / 24, rb = r % 24, p0 = rb * 64; ca = p0; cb = p0 + 32;
                if (p0 < 1280) { const int pn = p0 >> 8, bj = (p0 >> 7) & 1, q = p0 & 127; ca = pn * 256 + (q >> 5) * 64 + 32 * bj; cb = ca + 64; }
                t.f8 = false; t.dst = ws + WS_WQKV; W = inptr(c, 5); ldw = QKVD; t.k0 = kb * 64; t.rho0 = p0; t.gsc = inptr(c, 1) + D;
            } else {
                r -= I_QKV; const int kb = r >> 4, rb = r & 15;
                t.f8 = false; t.dst = ws + WS_WO; W = inptr(c, 8); ldw = D; ca = rb * 64; cb = ca + 32; t.k0 = kb * 64; t.rho0 = rb * 64;
            }
            if (wide) { t.src = W + (size_t)(t.k0 + (c.lane >> 3)) * ldw + ca + 4 * (c.lane & 7); t.ldw4 = (size_t)8 * ldw; }
            else { t.src = W + (size_t)(t.k0 + lr) * ldw + ((lq < 8) ? ca + 4 * lq : cb + 4 * (lq - 8)); t.ldw4 = (size_t)4 * ldw; }
        };
        TrItem cur, nxt; f32x4 va[16], vb[16];
        if (gw < NIT) { decode(gw, cur); tr_load(cur, va); }
        for (int it = gw; it < NIT; it += NGW) {
            const bool hn = it + NGW < NIT;
            if (hn) { decode(it + NGW, nxt); tr_load(nxt, vb); }
            tr_finish(cur, va, scr, c.lane);
            if (hn) { cur = nxt;
#pragma unroll
                for (int i = 0; i < 16; ++i) va[i] = vb[i]; }
        }
    }
    __syncthreads();
    LAS float* tab = (LAS float*)c.lds; LAS float* tab128 = tab + 4096;
    for (int k = c.tid; k < 4096; k += 512) tab[k] = cospif((float)k * (1.0f / 2048.0f));
    if (c.tid < 128) tab128[c.tid] = cospif((float)c.tid * (1.0f / 64.0f));
    __syncthreads();
    {
        float* TW = (float*)(ws + WS_TW);
        const int gt = c.v * 512 + c.tid;
        if (gt < 4096) { const int k1 = gt >> 6, bb = gt & 63; const float a = (float)(k1 * bb) * (1.0f / 2048.0f); TW[2 * gt] = cospif(a); TW[2 * gt + 1] = sinpif(a); }
    }
    {
        const float* wo = inptr(c, 3); bf16_t* WP = (bf16_t*)(ws + WS_WP);
        const float scale = 1.0f / sqrtf((float)SEQ * 128.0f);
        const int l15 = c.lane & 15, kq = c.lane >> 4;
        for (int task = c.wave * c.G + c.v; task < 1024; task += 8 * c.G) {
            const int half = task >> 9, g = (task >> 6) & 7, nb = task & 63;
            const float* wsrc = wo + (size_t)(g * 128 + kq) * D + nb * 16 + l15;
            float bvv[32];
#pragma unroll
            for (int ks = 0; ks < 32; ++ks) bvv[ks] = wsrc[(size_t)(4 * ks) * D];
            f32x4 a[8];
#pragma unroll
            for (int ccb = 0; ccb < 8; ++ccb) a[ccb] = (f32x4){0.f, 0.f, 0.f, 0.f};
#pragma unroll
            for (int ks = 0; ks < 32; ++ks) {
                const int cp = 4 * ks + kq;
#pragma unroll
                for (int ccb = 0; ccb < 8; ++ccb) {
                    const float tv = tab128[((ccb * 16 + l15) * cp - (half ? 32 : 0)) & 127];
                    a[ccb] = __builtin_amdgcn_mfma_f32_16x16x4f32(tv, bvv[ks], a[ccb], 0, 0, 0);
                }
            }
            const float sg = half ? -scale : scale;
            bf16_t* dst = WP + (size_t)half * D * D + (size_t)(nb * 16 + l15) * D + g * 128 + 4 * kq;
#pragma unroll
            for (int ccb = 0; ccb < 8; ++ccb) { u32x2 o; o.x = pk2(a[ccb][0] * sg, a[ccb][1] * sg); o.y = pk2(a[ccb][2] * sg, a[ccb][3] * sg); *(u32x2*)(dst + ccb * 16) = o; }
        }
    }
    {
        float* cosT = (float*)(ws + WS_COS); float* sinT = (float*)(ws + WS_SIN);
        const int gt = c.v * 512 + c.tid, NT_ = c.G * 512;
        for (int i = gt; i < SEQ * 32; i += NT_) {
            const int s = i >> 5, j = i & 31;
            const float inv_freq = powf(10000.0f, -(float)(2 * j) / 64.0f);
            const float ang = (float)s * inv_freq;
            cosT[i] = cosf(ang); sinT[i] = sinf(ang);
        }
    }
    __syncthreads();
    {
        const float* x = inptr(c, 0); const float* g = inptr(c, 1); bf16_t* HT = (bf16_t*)(ws + WS_HT);
        LAS bf16_t* tile = (LAS bf16_t*)c.lds; constexpr int TS = 1026;
        f32x4 gg[4];
#pragma unroll
        for (int j = 0; j < 4; ++j) gg[j] = *((const f32x4*)g + c.lane + 64 * j);
        for (int blk = c.v; blk < T / 64; blk += c.G) {
            const int bat = blk >> 6, b0 = blk & 63;
            f32x4 va[4][4], vb[4][4];
#pragma unroll
            for (int i = 0; i < 4; ++i) { const f32x4* xr = (const f32x4*)(x + ((size_t)bat * SEQ + 64 * (c.wave * 8 + i) + b0) * D) + c.lane;
#pragma unroll
                for (int j = 0; j < 4; ++j) va[i][j] = __builtin_nontemporal_load(xr + 64 * j); }
#pragma unroll
            for (int i = 0; i < 4; ++i) { const f32x4* xr = (const f32x4*)(x + ((size_t)bat * SEQ + 64 * (c.wave * 8 + 4 + i) + b0) * D) + c.lane;
#pragma unroll
                for (int j = 0; j < 4; ++j) vb[i][j] = __builtin_nontemporal_load(xr + 64 * j); }
#pragma unroll
            for (int i = 0; i < 8; ++i) {
                const int tl = c.wave * 8 + i;
                f32x4 v[4]; float s = 0.f;
#pragma unroll
                for (int j = 0; j < 4; ++j) { v[j] = (i < 4) ? va[i & 3][j] : vb[i & 3][j]; s += v[j].x * v[j].x + v[j].y * v[j].y + v[j].z * v[j].z + v[j].w * v[j].w; }
                const float r = rsqrtf(wave_sum(s) * (1.0f / D) + RMS_EPS);
#pragma unroll
                for (int j = 0; j < 4; ++j) {
                    u32x2 w; w.x = pk2(v[j].x * r * gg[j].x, v[j].y * r * gg[j].y); w.y = pk2(v[j].z * r * gg[j].z, v[j].w * r * gg[j].w);
                    LAS unsigned* tp = (LAS unsigned*)(tile + tl * TS + 256 * j + 4 * c.lane); tp[0] = w.x; tp[1] = w.y;
                }
            }
            __syncthreads();
            for (int it = c.tid; it < 1024 * 8; it += 512) {
                const int o8 = it & 7, ch = it >> 3;
                unsigned short e[8];
#pragma unroll
                for (int j = 0; j < 8; ++j) e[j] = tile[(o8 * 8 + j) * TS + ch];
                u32x4 o; o.x = e[0] | ((unsigned)e[1] << 16); o.y = e[2] | ((unsigned)e[3] << 16); o.z = e[4] | ((unsigned)e[5] << 16); o.w = e[6] | ((unsigned)e[7] << 16);
                *(u32x4*)(HT + (((size_t)bat * D + ch) * 64 + b0) * 64 + o8 * 8) = o;
            }
            __syncthreads();
        }
    }
}

struct F64Frags { bf16x8 C[2][4], S[2][4]; };
DEVI void make_f64(const Ctx& c, F64Frags& f) {
    LAS float* tab = (LAS float*)c.lds;
    __syncthreads();
    if (c.tid < 64) tab[c.tid] = cospif((float)c.tid * (1.0f / 32.0f));
    __syncthreads();
    const int r32 = c.lane & 31, hi = c.lane >> 5;
#pragma unroll
    for (int t = 0; t < 2; ++t)
#pragma unroll
        for (int ks = 0; ks < 4; ++ks) {
            union { bf16x8 v; unsigned w[4]; } cv, sv;
#pragma unroll
            for (int j = 0; j < 4; ++j) {
                const int q = r32 + 32 * t, k0 = 16 * ks + 8 * hi + 2 * j, i0 = (q * k0) & 63, i1 = (q * (k0 + 1)) & 63;
                cv.w[j] = pk2(tab[i0], tab[i1]); sv.w[j] = pk2(tab[(i0 - 16) & 63], tab[(i1 - 16) & 63]);
            }
            f.C[t][ks] = cv.v; f.S[t][ks] = sv.v;
        }
}
constexpr int FFT_STG = 2 * 64 * 33 * 4;
static_assert(8 * FFT_STG <= LDSCTL_OFF, "fft stage fits under the LDS control area");
DEVI void fft1_phase(const Ctx& c0, const bf16_t* HT2, const float* TW, bf16_t* Y2) {
    const Ctx c = refresh(c0);
    F64Frags f; make_f64(c, f);
    __syncthreads();
    LAS unsigned* stg = (LAS unsigned*)(c.lds + c.wave * FFT_STG);
    const int r32 = c.lane & 31, hi = c.lane >> 5;
    const int gw = c.v * 8 + c.wave, NGW = c.G * 8;
    bf16x8 xn[4];
    if (gw < BATCH * D) {
#pragma unroll
        for (int ks = 0; ks < 4; ++ks) xn[ks] = __builtin_nontemporal_load((const bf16x8*)(HT2 + (size_t)gw * 4096 + r32 * 64 + 16 * ks + 8 * hi));
    }
    for (int item = gw; item < BATCH * D; item += NGW) {
        const int bat = item >> 10, ch = item & 1023;
#pragma unroll 1
        for (int bt = 0; bt < 2; ++bt) {
            bf16x8 xf[4];
#pragma unroll
            for (int ks = 0; ks < 4; ++ks) xf[ks] = xn[ks];
            {
                const int nitem = bt ? item + NGW : item, nbt = bt ^ 1;
                if (nitem < BATCH * D) {
#pragma unroll
                    for (int ks = 0; ks < 4; ++ks) xn[ks] = __builtin_nontemporal_load((const bf16x8*)(HT2 + (size_t)nitem * 4096 + (32 * nbt + r32) * 64 + 16 * ks + 8 * hi));
                }
            }
            f32x16 P, Q;
#pragma unroll
            for (int i = 0; i < 16; ++i) { P[i] = 0.f; Q[i] = 0.f; }
            float p32 = 0.f;
#pragma unroll
            for (int ks = 0; ks < 4; ++ks) {
                P = __builtin_amdgcn_mfma_f32_32x32x16_bf16(xf[ks], f.C[0][ks], P, 0, 0, 0);
                Q = __builtin_amdgcn_mfma_f32_32x32x16_bf16(xf[ks], f.S[0][ks], Q, 0, 0, 0);
#pragma unroll
                for (int j = 0; j < 8; ++j) { const float xv = __builtin_bit_cast(float, (unsigned)(unsigned short)xf[ks][j] << 16); p32 += (j & 1) ? -xv : xv; }
            }
            p32 = sum32(p32);
            {
                const int k1 = r32;
#pragma unroll
                for (int i = 0; i < 4; ++i) {
                    const int b0 = 32 * bt + 8 * i + 4 * hi;
                    const f32x4 t0 = *(const f32x4*)(TW + (k1 * 64 + b0) * 2), t1 = *(const f32x4*)(TW + (k1 * 64 + b0) * 2 + 4);
                    const float cs[4] = {t0.x, t0.z, t1.x, t1.z}, sn[4] = {t0.y, t0.w, t1.y, t1.w};
                    float tr[4], ti[4];
#pragma unroll
                    for (int j = 0; j < 4; ++j) { const float pp = P[4 * i + j], qq = Q[4 * i + j]; tr[j] = pp * cs[j] - qq * sn[j]; ti[j] = pp * sn[j] + qq * cs[j]; }
                    LAS unsigned* sp = stg + k1 * 33 + (b0 >> 1);
                    sp[0] = pk2(tr[0], tr[1]); sp[1] = pk2(tr[2], tr[3]);
                    sp[64 * 33] = pk2(ti[0], ti[1]); sp[64 * 33 + 1] = pk2(ti[2], ti[3]);
                }
            }
            {
                const int b = 32 * bt + r32;
                const f32x2 tw = *(const f32x2*)(TW + (32 * 64 + b) * 2);
                ((LAS unsigned short*)(stg + (hi ? 64 * 33 : 0) + 32 * 33))[b] = (unsigned short)f2bf(p32 * (hi ? tw.y : tw.x));
            }
        }
        asm volatile("s_waitcnt lgkmcnt(0)" ::: "memory");
#pragma unroll
        for (int it = 0; it < 8; ++it) {
            const int part = it >> 2, row = (it & 3) * 8 + (c.lane >> 3), chunk = c.lane & 7;
            const LAS unsigned* sp = stg + (part * 64 + row) * 33 + chunk * 4;
            u32x4 w; w.x = sp[0]; w.y = sp[1]; w.z = sp[2]; w.w = sp[3];
            *(u32x4*)(Y2 + ((((size_t)bat * 64 + row) * 2 + part) * 1024 + ch) * 64 + chunk * 8) = w;
        }
        if (c.lane < 16) {
            const int part = c.lane >> 3, chunk = c.lane & 7;
            const LAS unsigned* sp = stg + (part * 64 + 32) * 33 + chunk * 4;
            u32x4 w; w.x = sp[0]; w.y = sp[1]; w.z = sp[2]; w.w = sp[3];
            *(u32x4*)(Y2 + ((((size_t)bat * 64 + 32) * 2 + part) * 1024 + ch) * 64 + chunk * 8) = w;
        }
        asm volatile("s_waitcnt lgkmcnt(0)" ::: "memory");
    }
}
DEVI void fft2_phase(const Ctx& c0, const bf16_t* Y2, bf16_t* UB, bf16_t* VB, bf16_t* U2048) {
    const Ctx c = refresh(c0);
    F64Frags f; make_f64(c, f);
    __syncthreads();
    LAS unsigned* stg = (LAS unsigned*)(c.lds + c.wave * FFT_STG);
    const int r32 = c.lane & 31, hi = c.lane >> 5;
    const int gw = c.v * 8 + c.wave, NGW = c.G * 8;
    bf16x8 trn[4], tin[4];
#define F2_BAT(it_) ((it_) < 4096 ? (it_) >> 9 : ((it_) - 4096) >> 4)
#define F2_K1(it_) ((it_) < 4096 ? ((it_) >> 4) & 31 : 32)
#define F2_ADDR(it_, sub_) (Y2 + ((((size_t)F2_BAT(it_) * 64 + F2_K1(it_)) * 2) * 1024 + 64 * ((it_) & 15) + 32 * (sub_) + r32) * 64 + 8 * hi)
    constexpr int NIT2 = BATCH * 33 * 16;
    if (gw < NIT2) {
        const bf16_t* yb = F2_ADDR(gw, 0);
#pragma unroll
        for (int ks = 0; ks < 4; ++ks) { trn[ks] = __builtin_nontemporal_load((const bf16x8*)(yb + 16 * ks)); tin[ks] = __builtin_nontemporal_load((const bf16x8*)(yb + 1024 * 64 + 16 * ks)); }
    }
    for (int item = gw; item < NIT2; item += NGW) {
        const int ct = item & 15, k1 = F2_K1(item), bat = F2_BAT(item), c0 = 64 * ct;
#pragma unroll 1
        for (int sub = 0; sub < 2; ++sub) {
            bf16x8 trf[4], tif[4], ntf[4];
#pragma unroll
            for (int ks = 0; ks < 4; ++ks) { trf[ks] = trn[ks]; tif[ks] = tin[ks]; ntf[ks] = tif[ks] ^ (short)0x8000; }
            {
                const int nitem = sub ? item + NGW : item, nsub = sub ^ 1;
                if (nitem < NIT2) {
                    const bf16_t* yb = F2_ADDR(nitem, nsub);
#pragma unroll
                    for (int ks = 0; ks < 4; ++ks) { trn[ks] = __builtin_nontemporal_load((const bf16x8*)(yb + 16 * ks)); tin[ks] = __builtin_nontemporal_load((const bf16x8*)(yb + 1024 * 64 + 16 * ks)); }
                }
            }
            f32x16 U[2], V[2];
            const int nkt = (k1 == 32) ? 1 : 2;
#pragma unroll
            for (int kt = 0; kt < 2; ++kt) {
                if (kt >= nkt) break;
#pragma unroll
                for (int i = 0; i < 16; ++i) { U[kt][i] = 0.f; V[kt][i] = 0.f; }
#pragma unroll
                for (int ks = 0; ks < 4; ++ks) {
                    U[kt] = __builtin_amdgcn_mfma_f32_32x32x16_bf16(trf[ks], f.C[kt][ks], U[kt], 0, 0, 0);
                    U[kt] = __builtin_amdgcn_mfma_f32_32x32x16_bf16(ntf[ks], f.S[kt][ks], U[kt], 0, 0, 0);
                    V[kt] = __builtin_amdgcn_mfma_f32_32x32x16_bf16(tif[ks], f.C[kt][ks], V[kt], 0, 0, 0);
                    V[kt] = __builtin_amdgcn_mfma_f32_32x32x16_bf16(trf[ks], f.S[kt][ks], V[kt], 0, 0, 0);
                }
            }
#pragma unroll
            for (int kt = 0; kt < 2; ++kt) {
                if (kt >= nkt) break;
#pragma unroll
                for (int i = 0; i < 4; ++i) {
                    LAS unsigned* sp = stg + (r32 + 32 * kt) * 33 + ((32 * sub + 8 * i + 4 * hi) >> 1);
                    sp[0] = pk2(U[kt][4 * i], U[kt][4 * i + 1]); sp[1] = pk2(U[kt][4 * i + 2], U[kt][4 * i + 3]);
                    sp[64 * 33] = pk2(V[kt][4 * i], V[kt][4 * i + 1]); sp[64 * 33 + 1] = pk2(V[kt][4 * i + 2], V[kt][4 * i + 3]);
                }
            }
        }
        asm volatile("s_waitcnt lgkmcnt(0)" ::: "memory");
#pragma unroll
        for (int it = 0; it < 8; ++it) {
            const int part = it >> 2, row = (it & 3) * 8 + (c.lane >> 3), chunk = c.lane & 7;
            const LAS unsigned* sp = stg + (part * 64 + row) * 33 + chunk * 4;
            u32x4 w; w.x = sp[0]; w.y = sp[1]; w.z = sp[2]; w.w = sp[3];
            *(u32x4*)((part ? VB : UB) + ((size_t)bat * 2048 + k1 + 64 * row) * D + c0 + chunk * 8) = w;
        }
        if (k1 >= 1 && k1 < 32) {
#pragma unroll
            for (int it = 0; it < 8; ++it) {
                const int part = it >> 2, row = 32 + (it & 3) * 8 + (c.lane >> 3), chunk = c.lane & 7;
                const LAS unsigned* sp = stg + (part * 64 + row) * 33 + chunk * 4;
                const unsigned sg = part ? 0x80008000u : 0u;
                u32x4 w; w.x = sp[0] ^ sg; w.y = sp[1] ^ sg; w.z = sp[2] ^ sg; w.w = sp[3] ^ sg;
                *(u32x4*)((part ? VB : UB) + ((size_t)bat * 2048 + (64 - k1) + 64 * (63 - row)) * D + c0 + chunk * 8) = w;
            }
        }
        if (k1 == 0 && c.lane < 8) {
            const LAS unsigned* sp = stg + 32 * 33 + c.lane * 4;
            u32x4 w; w.x = sp[0]; w.y = sp[1]; w.z = sp[2]; w.w = sp[3];
            *(u32x4*)(U2048 + (size_t)bat * D + c0 + c.lane * 8) = w;
        }
        asm volatile("s_waitcnt lgkmcnt(0)" ::: "memory");
    }
#undef F2_ADDR
#undef F2_BAT
#undef F2_K1
}

template <bool F8>
DEVI void router_phase(const Ctx& c0, const bf16_t* X, const float* g, const float* rw, const float* rb, unsigned char* HN, int* idx, float* gate, int* rank, unsigned* cnt, int* bbase, int* slot_tok) {
    const Ctx c = refresh(c0);
    for (int i = c.v * 512 + c.tid; i < NSLOT; i += c.G * 512) slot_tok[i] = 0;
    constexpr int WROW = 1032;
    LAS unsigned short* whi = (LAS unsigned short*)c.lds; LAS unsigned short* wlo = whi + 32 * WROW;
    LAS int* hist = (LAS int*)(c.lds + LDSCTL_OFF + LC_HIST);
    for (int it = c.tid; it < 8192; it += 512) {
        const f32x4 w = *((const f32x4*)rw + it); const int d = it >> 3, e0 = (it & 7) * 4; const float gd = g[d];
#pragma unroll
        for (int j = 0; j < 4; ++j) { const float v = w[j] * gd; const unsigned h = f2bf(v); const unsigned l = f2bf(v - __builtin_bit_cast(float, h << 16));
            const int e = e0 + j, slot = (e & 1) * 16 + (e >> 1); whi[slot * WROW + d] = (unsigned short)h; wlo[slot * WROW + d] = (unsigned short)l; }
    }
    if (c.tid < 32) hist[c.tid] = 0;
    __syncthreads();
    f32x4 gg[2][2];
#pragma unroll
    for (int jj = 0; jj < 2; ++jj) { gg[jj][0] = *(const f32x4*)(g + 512 * jj + 8 * c.lane); gg[jj][1] = *(const f32x4*)(g + 512 * jj + 8 * c.lane + 4); }
    const int tl = c.lane & 15, q = c.lane >> 4;
    const bool hi32 = c.lane >= 32;
    for (int ci = c.v; ci < T / 128; ci += c.G) {
        const int t0 = ci * 128 + c.wave * 16;
        const bf16_t* xp = X + (size_t)(t0 + tl) * D + 8 * q;
        const LAS unsigned short* wp = whi + tl * WROW + 8 * q;
        f32x4 acc0 = {0.f, 0.f, 0.f, 0.f}, acc1 = {0.f, 0.f, 0.f, 0.f};
        float ss = 0.f;
        u32x4 xa[32];
#pragma unroll
        for (int U = 0; U < 32; ++U) xa[U] = *(const u32x4*)(xp + 32 * U);
#pragma unroll
        for (int U = 0; U < 32; ++U) {
            const u32x4 xw = xa[U];
            const float xv[8] = {bflo(xw.x), bfhi(xw.x), bflo(xw.y), bfhi(xw.y), bflo(xw.z), bfhi(xw.z), bflo(xw.w), bfhi(xw.w)};
#pragma unroll
            for (int i = 0; i < 8; ++i) ss += xv[i] * xv[i];
            const bf16x8 xb8 = __builtin_bit_cast(bf16x8, xw);
            const bf16x8 h0 = *(const LAS bf16x8*)(wp + 32 * U), h1 = *(const LAS bf16x8*)(wp + 16 * WROW + 32 * U);
            const bf16x8 l0 = *(const LAS bf16x8*)(wp + 32 * WROW + 32 * U), l1 = *(const LAS bf16x8*)(wp + 48 * WROW + 32 * U);
            acc0 = __builtin_amdgcn_mfma_f32_16x16x32_bf16(h0, xb8, acc0, 0, 0, 0); acc1 = __builtin_amdgcn_mfma_f32_16x16x32_bf16(h1, xb8, acc1, 0, 0, 0);
            acc0 = __builtin_amdgcn_mfma_f32_16x16x32_bf16(l0, xb8, acc0, 0, 0, 0); acc1 = __builtin_amdgcn_mfma_f32_16x16x32_bf16(l1, xb8, acc1, 0, 0, 0);
        }
        ss += xor_f32<16>(ss, hi32); ss += xor_f32<32>(ss, hi32);
        const float r = rsqrtf(ss * (1.0f / D) + RMS_EPS);
        float lv[8];
#pragma unroll
        for (int rr = 0; rr < 4; ++rr) { lv[2 * rr] = acc0[rr] * r + rb[2 * (4 * q + rr)]; lv[2 * rr + 1] = acc1[rr] * r + rb[2 * (4 * q + rr) + 1]; }
        float topv[4]; int topi[4];
#pragma unroll
        for (int k = 0; k < 4; ++k) {
            float bv = lv[0]; int bi = 8 * q;
#pragma unroll
            for (int n = 1; n < 8; ++n) if (lv[n] > bv) { bv = lv[n]; bi = 8 * q + n; }
#define AM_STEP(O) { const float ov = xor_f32<O>(bv, hi32); const int oi = (int)xor_u32<O>((unsigned)bi, hi32); if (ov > bv || (ov == bv && oi < bi)) { bv = ov; bi = oi; } }
            AM_STEP(16) AM_STEP(32)
#undef AM_STEP
            topv[k] = bv; topi[k] = bi;
#pragma unroll
            for (int n = 0; n < 8; ++n) if (bi == 8 * q + n) lv[n] = -INFINITY;
        }
        float ex[4], sum = 0.f;
#pragma unroll
        for (int k = 0; k < 4; ++k) { ex[k] = __expf(topv[k] - topv[0]); sum += ex[k]; }
        if (c.lane < 16) {
            const int t = t0 + tl; const float inv = 1.0f / sum;
#pragma unroll
            for (int k = 0; k < 4; ++k) { idx[t * 4 + k] = topi[k]; gate[t * 4 + k] = ex[k] * inv; rank[t * 4 + k] = __hip_atomic_fetch_add(&hist[topi[k]], 1, __ATOMIC_RELAXED, __HIP_MEMORY_SCOPE_WORKGROUP); }
        }
#pragma unroll 8
        for (int i = 0; i < 16; ++i) {
            const float ri = __builtin_bit_cast(float, __builtin_amdgcn_readlane(__builtin_bit_cast(int, r), i));
            const int t = t0 + i;
#pragma unroll
            for (int jj = 0; jj < 2; ++jj) {
                const u32x4 xw = *(const u32x4*)(X + (size_t)t * D + 512 * jj + 8 * c.lane);
                const f32x4 h0 = (f32x4){bflo(xw.x), bfhi(xw.x), bflo(xw.y), bfhi(xw.y)} * ri * gg[jj][0], h1 = (f32x4){bflo(xw.z), bfhi(xw.z), bflo(xw.w), bfhi(xw.w)} * ri * gg[jj][1];
                if (F8) { u32x2 w; w.x = pk4f8(h0[0], h0[1], h0[2], h0[3]); w.y = pk4f8(h1[0], h1[1], h1[2], h1[3]); *(u32x2*)(HN + (size_t)t * D + 512 * jj + 8 * c.lane) = w; }
                else { u32x4 w; w.x = pk2(h0[0], h0[1]); w.y = pk2(h0[2], h0[3]); w.z = pk2(h1[0], h1[1]); w.w = pk2(h1[2], h1[3]); *(u32x4*)(HN + ((size_t)t * D + 512 * jj + 8 * c.lane) * 2) = w; }
            }
        }
        __syncthreads();
        if (c.tid < 32) { const int h = hist[c.tid]; bbase[ci * 32 + c.tid] = (int)__hip_atomic_fetch_add(&cnt[c.tid], (unsigned)h, RLX_AGENT); hist[c.tid] = 0; }
        __syncthreads();
    }
}

DEVI void moe_plan(const Ctx& c0, const unsigned* cnt) {
    const Ctx c = refresh(c0);
    LAS int* pst = (LAS int*)(c.lds + LDSCTL_OFF + LC_PST); LAS int* ntl = (LAS int*)(c.lds + LDSCTL_OFF + LC_NT); LAS int* tile_e = (LAS int*)(c.lds + LDSCTL_OFF + LC_TILEE);
    if (c.tid < 64) {
        const int e = c.tid; const int cn = (e < NE) ? (int)__hip_atomic_load(&cnt[e], RLX_AGENT) : 0;
        const int padded = ((cn + MT - 1) / MT) * MT;
        if (e < NE) pst[e] = padded;
        asm volatile("s_waitcnt lgkmcnt(0)" ::: "memory");
        int st = 0;
        for (int j = 0; j < NE; ++j) { const int pj = pst[j]; st += (j < e) ? pj : 0; }
        asm volatile("s_waitcnt lgkmcnt(0)" ::: "memory");
        const int incl = st + padded;
        if (e < NE) { pst[e] = st; for (int i = st / MT; i < incl / MT; ++i) tile_e[i] = e; if (e == NE - 1) ntl[0] = incl / MT; }
    }
    __syncthreads();
}

DEVI void scatter_phase(const Ctx& c0, const unsigned* cnt, const int* idx, const int* rank, const int* bbase, int* slot_of, int* slot_tok) {
    const Ctx c = refresh(c0);
    moe_plan(c, cnt);
    const LAS int* pst = (const LAS int*)(c.lds + LDSCTL_OFF + LC_PST);
    for (int ci = c.v; ci < T / 128; ci += c.G) {
        const int i = ci * 512 + c.tid;
        const int e = idx[i], slot = pst[e] + bbase[ci * 32 + e] + rank[i];
        slot_of[i] = slot; slot_tok[slot] = i >> 2;
    }
}

template <bool FINAL>
DEVI void combine_phase(const Ctx& c0, bf16_t* X, const bf16_t* Y, const float* gate, const int* slot_of, const float* gn, float* RS, float* OUT) {
    const Ctx c = refresh(c0);
    const int gw = c.v * 8 + c.wave, NGW = c.G * 8;
    f32x4 gg[2][2];
#pragma unroll
    for (int jj = 0; jj < 2; ++jj) { gg[jj][0] = *(const f32x4*)(gn + 512 * jj + 8 * c.lane); gg[jj][1] = *(const f32x4*)(gn + 512 * jj + 8 * c.lane + 4); }
    for (int blk = gw; blk < T / 16; blk += NGW) {
        const int t0 = blk * 16;
        const int myslot = slot_of[t0 * 4 + c.lane]; const float mygate = gate[t0 * 4 + c.lane];
#pragma unroll 1
        for (int i = 0; i < 16; i += 2) {
            f32x4 v[2][2][2]; u32x4 y[2][4][2];
#pragma unroll
            for (int u = 0; u < 2; ++u) {
                const bf16_t* xr = X + (size_t)(t0 + i + u) * D + 8 * c.lane;
#pragma unroll
                for (int jj = 0; jj < 2; ++jj) { const u32x4 xw = *(const u32x4*)(xr + 512 * jj); v[u][jj][0] = (f32x4){bflo(xw.x), bfhi(xw.x), bflo(xw.y), bfhi(xw.y)}; v[u][jj][1] = (f32x4){bflo(xw.z), bfhi(xw.z), bflo(xw.w), bfhi(xw.w)}; }
#pragma unroll
                for (int k = 0; k < 4; ++k) {
                    const int slot = __builtin_amdgcn_readlane(myslot, (i + u) * 4 + k);
                    const unsigned char* yr = (const unsigned char*)Y + (size_t)slot * D + 8 * c.lane;
                    const u32x2 ya = __builtin_nontemporal_load((const u32x2*)yr), yb = __builtin_nontemporal_load((const u32x2*)(yr + 512));
                    y[u][k][0] = (u32x4){ya.x, ya.y, 0u, 0u}; y[u][k][1] = (u32x4){yb.x, yb.y, 0u, 0u};
                }
            }
#pragma unroll
            for (int u = 0; u < 2; ++u) {
                const int t = t0 + i + u;
#pragma unroll
                for (int k = 0; k < 4; ++k) {
                    const float gk = __builtin_bit_cast(float, __builtin_amdgcn_readlane(__builtin_bit_cast(int, mygate), (i + u) * 4 + k));
#pragma unroll
                    for (int jj = 0; jj < 2; ++jj) {
                        const u32x4 yy = y[u][k][jj];
                        const f32x2 p0 = __builtin_amdgcn_cvt_pk_f32_fp8((int)yy.x, false), p1 = __builtin_amdgcn_cvt_pk_f32_fp8((int)yy.x, true), p2 = __builtin_amdgcn_cvt_pk_f32_fp8((int)yy.y, false), p3 = __builtin_amdgcn_cvt_pk_f32_fp8((int)yy.y, true);
                        v[u][jj][0].x += gk * p0.x; v[u][jj][0].y += gk * p0.y; v[u][jj][0].z += gk * p1.x; v[u][jj][0].w += gk * p1.y;
                        v[u][jj][1].x += gk * p2.x; v[u][jj][1].y += gk * p2.y; v[u][jj][1].z += gk * p3.x; v[u][jj][1].w += gk * p3.y;
                    }
                }
                float s = 0.f;
#pragma unroll
                for (int jj = 0; jj < 2; ++jj)
#pragma unroll
                    for (int h = 0; h < 2; ++h) { const f32x4 a = v[u][jj][h]; s += a.x * a.x + a.y * a.y + a.z * a.z + a.w * a.w; }
                const float r = rsqrtf(wave_sum(s) * (1.0f / D) + RMS_EPS);
                bf16_t* xr = X + (size_t)t * D + 8 * c.lane;
                if (!FINAL && c.lane == 0) RS[t] = r;
#pragma unroll
                for (int jj = 0; jj < 2; ++jj) {
                    if (FINAL) { const f32x4 a0 = v[u][jj][0] * r * gg[jj][0], a1 = v[u][jj][1] * r * gg[jj][1]; float* o = OUT + (size_t)t * D + 8 * c.lane + 512 * jj; *(f32x4*)o = a0; *(f32x4*)(o + 4) = a1; }
                    else { const f32x4 x0 = v[u][jj][0], x1 = v[u][jj][1]; u32x4 xw; xw.x = pk2(x0.x, x0.y); xw.y = pk2(x0.z, x0.w); xw.z = pk2(x1.x, x1.y); xw.w = pk2(x1.z, x1.w); *(u32x4*)(xr + 512 * jj) = xw; }
                }
            }
        }
    }
}

constexpr int AT_KOFF = 0, AT_VOFF = 49152, AT_VS = 776;
DEVI void attn_phase(const Ctx& c0, const bf16_t* Q, const bf16_t* Kb, const bf16_t* VT, const float* sink, bf16_t* O) {
    const Ctx c = refresh(c0);
    LAS unsigned char* lds = c.lds;
    const int r32 = c.lane & 31, hi = c.lane >> 5;
    for (int L = c.v; L < 1024; L += c.G) {
        const int b = L >> 7, kv = (L >> 5) & 3, qb = L & 31;
        const int kpos0 = (qb - 1) * 128;
        __syncthreads();
        for (int ch = c.tid; ch < 3072; ch += 512) {
            const int row = ch >> 3, cc = ch & 7, kpos = kpos0 + row;
            if (kpos >= 0 && kpos < SEQ) {
                const u32x4 v = *(const u32x4*)(Kb + (size_t)(b * SEQ + kpos) * 256 + kv * 64 + cc * 8);
                *(LAS u32x4*)(lds + AT_KOFF + row * 128 + ((cc ^ ((row >> 1) & 7)) << 4)) = v;
            }
        }
        for (int ch = c.tid; ch < 3072; ch += 512) {
            const int d = ch / 48, kc = ch % 48, kpos = kpos0 + kc * 8;
            if (kpos >= 0 && kpos < SEQ) {
                const u32x4 v = *(const u32x4*)(VT + (size_t)(kv * 64 + d) * T + b * SEQ + kpos);
                LAS u32x2* dp = (LAS u32x2*)(lds + AT_VOFF + d * AT_VS + kc * 16);
                dp[0] = (u32x2){v.x, v.y}; dp[1] = (u32x2){v.z, v.w};
            }
        }
        __syncthreads();
        const int g = c.wave >> 1, hq = kv * 4 + g;
        const float snk = sink[hq];
        const int jlo = (qb == 0) ? 1 : 0, jhi = (qb == 31) ? 2 : 3;
        for (int qc = 0; qc < 2; ++qc) {
            const int ql0 = (c.wave & 1) * 64 + qc * 32;
            const size_t trow = (size_t)b * SEQ + qb * 128 + ql0 + r32;
            bf16x8 qf[4];
#pragma unroll
            for (int ks = 0; ks < 4; ++ks) qf[ks] = *(const bf16x8*)(Q + trow * D + hq * 64 + ks * 16 + hi * 8);
            float m = snk * 1.4426950408889634f, l = 1.0f;
            f32x16 o0, o1;
#pragma unroll
            for (int i = 0; i < 16; ++i) { o0[i] = 0.f; o1[i] = 0.f; }
            const int qc4 = ql0 >> 5;
            for (int jb = jlo; jb < jhi; ++jb) {
                f32x16 s[4];
#pragma unroll
                for (int kt = 0; kt < 4; ++kt) {
                    const bool act = (jb == 1) || (jb == 0 ? kt >= qc4 : kt <= qc4);
                    if (act) {
#pragma unroll
                        for (int i = 0; i < 16; ++i) s[kt][i] = 0.f;
                        const int row = jb * 128 + kt * 32 + r32;
#pragma unroll
                        for (int ks = 0; ks < 4; ++ks) {
                            const bf16x8 kf = *(const LAS bf16x8*)(lds + AT_KOFF + row * 128 + (((2 * ks + hi) ^ ((row >> 1) & 7)) << 4));
                            s[kt] = __builtin_amdgcn_mfma_f32_32x32x16_bf16(kf, qf[ks], s[kt], 0, 0, 0);
                        }
                    }
                }
                float mx = -1e30f;
#pragma unroll
                for (int kt = 0; kt < 4; ++kt) {
                    const bool act = (jb == 1) || (jb == 0 ? kt >= qc4 : kt <= qc4);
                    if (act) {
                        if (jb != 1 && kt == qc4) {
                            const int sg = (jb == 0) ? 1 : -1;
                            int tq = sg * (4 * hi - r32); asm volatile("" : "+v"(tq));
#pragma unroll
                            for (int i = 0; i < 16; ++i) {
                                const int kc = (i & 3) + 8 * (i >> 2);
                                const float sv = (sg * kc + tq >= 0) ? s[kt][i] : -1e30f;
                                s[kt][i] = sv; mx = fmaxf(mx, sv);
                            }
                        } else {
#pragma unroll
                            for (int i = 0; i < 16; ++i) mx = fmaxf(mx, s[kt][i]);
                        }
                    }
                }
                mx = max32(mx);
                const float mn = fmaxf(m, mx), alpha = __builtin_amdgcn_exp2f(m - mn);
                float ps = 0.f;
#pragma unroll
                for (int kt = 0; kt < 4; ++kt) {
                    const bool act = (jb == 1) || (jb == 0 ? kt >= qc4 : kt <= qc4);
                    if (act) {
#pragma unroll
                        for (int i = 0; i < 16; ++i) { const float pv = __builtin_amdgcn_exp2f(s[kt][i] - mn); s[kt][i] = pv; ps += pv; }
                    }
                }
                ps = sum32(ps);
                l = l * alpha + ps; m = mn;
#pragma unroll
                for (int i = 0; i < 16; ++i) { o0[i] *= alpha; o1[i] *= alpha; }
#pragma unroll
                for (int kt = 0; kt < 4; ++kt) {
                    const bool act = (jb == 1) || (jb == 0 ? kt >= qc4 : kt <= qc4);
                    if (act) {
#pragma unroll
                        for (int s2 = 0; s2 < 2; ++s2) {
                            union { bf16x8 v; unsigned w[4]; } pf;
#pragma unroll
                            for (int j = 0; j < 4; ++j) pf.w[j] = pk2(s[kt][8 * s2 + 2 * j], s[kt][8 * s2 + 2 * j + 1]);
                            const int key = jb * 128 + kt * 32 + s2 * 16 + 4 * hi;
#pragma unroll
                            for (int dt = 0; dt < 2; ++dt) {
                                const LAS unsigned char* vp = lds + AT_VOFF + (dt * 32 + r32) * AT_VS + key * 2;
                                union { bf16x8 v; u32x2 h[2]; } vf;
                                vf.h[0] = *(const LAS u32x2*)vp; vf.h[1] = *(const LAS u32x2*)(vp + 16);
                                if (dt == 0) o0 = __builtin_amdgcn_mfma_f32_32x32x16_bf16(vf.v, pf.v, o0, 0, 0, 0);
                                else o1 = __builtin_amdgcn_mfma_f32_32x32x16_bf16(vf.v, pf.v, o1, 0, 0, 0);
                            }
                        }
                    }
                }
            }
            const float inv = 1.0f / l;
            bf16_t* op = O + trow * D + hq * 64 + 4 * hi;
#pragma unroll
            for (int i = 0; i < 4; ++i) {
                u32x2 w; w.x = pk2(o0[4 * i] * inv, o0[4 * i + 1] * inv); w.y = pk2(o0[4 * i + 2] * inv, o0[4 * i + 3] * inv);
                *(u32x2*)(op + 8 * i) = w;
                w.x = pk2(o1[4 * i] * inv, o1[4 * i + 1] * inv); w.y = pk2(o1[4 * i + 2] * inv, o1[4 * i + 3] * inv);
                *(u32x2*)(op + 32 + 8 * i) = w;
            }
        }
    }
}

struct Args { In in; float* out; unsigned char* ws; int ph_lo, ph_hi, li, pad; };

__global__ void __launch_bounds__(512, 2) mk_fwd(Args args) {
    extern __shared__ __attribute__((aligned(16))) unsigned char lds_raw[];
    Ctx c; c.lds = (LAS unsigned char*)lds_raw;
    c.tid = threadIdx.x; c.lane = c.tid & 63; c.wave = __builtin_amdgcn_readfirstlane(c.tid >> 6);
    c.G = gridDim.x; { const int bx = blockIdx.x; c.v = (c.G % 8 == 0) ? (bx % 8) * (c.G / 8) + bx / 8 : bx; }
    unsigned char* ws = args.ws;
    for (int u = c.tid; u < (LDS_BYTES - LDSCTL_OFF) / 4; u += 512) ((LAS unsigned*)(c.lds + LDSCTL_OFF))[u] = 0u;
    __syncthreads();
    if (c.tid == 0) {
        LAS unsigned long long* pt = (LAS unsigned long long*)(c.lds + LDSCTL_OFF + LC_PTRS);
#define PT(i) pt[i] = (unsigned long long)args.in.p[i];
        PT(0) PT(1) PT(2) PT(3) PT(4) PT(5) PT(6) PT(7) PT(8) PT(9) PT(10) PT(11) PT(12) PT(13) PT(14) PT(15) PT(16)
#undef PT
        pt[17] = (unsigned long long)args.out;
    }
    if (MK_N_LAUNCHES == 1) (void)xcd_barrier_post((unsigned*)(ws + WS_CTL) + CW_BAR, (volatile LAS unsigned*)(c.lds + LDSCTL_OFF + LC_BARST));
    __syncthreads();
    const int lo = args.ph_lo, hi = args.ph_hi;
#ifndef PHMASK
#define PHMASK 0xFFFF
#endif
#define IN(k) (((PHMASK >> ((k) > 10 ? (k) - 8 : (k))) & 1) && lo <= (k) && (k) < hi)
#define SEAM(k) do { if (IN(k) && IN((k) + 1)) { XcdBarrier bar_; bar_.bar = (unsigned*)(ws + WS_CTL) + CW_BAR; bar_.x = xb_xcc_id(); bar_.st = (volatile LAS unsigned*)(c.lds + LDSCTL_OFF + LC_BARST); xcd_barrier(bar_); } } while (0)
#define GBAR() do { XcdBarrier bar_; bar_.bar = (unsigned*)(ws + WS_CTL) + CW_BAR; bar_.x = xb_xcc_id(); bar_.st = (volatile LAS unsigned*)(c.lds + LDSCTL_OFF + LC_BARST); xcd_barrier(bar_); } while (0)
#ifndef DUPMASK
#define DUPMASK 0
#endif
#define RUNPH(k, ...) do { if (IN(k)) { __VA_ARGS__ if ((DUPMASK >> (k)) & 1) { GBAR(); __VA_ARGS__ } } } while (0)
#define XOUT ((float*)inptr(c, 17))
#define XRES ((bf16_t*)(ws + WS_XB))
#define WSP(T_, off) ((T_*)(ws + (off)))
    const LAS int* tile_e = (const LAS int*)(c.lds + LDSCTL_OFF + LC_TILEE); const LAS int* ntl = (const LAS int*)(c.lds + LDSCTL_OFF + LC_NT);

    RUNPH(0, { p0_prologue(c, ws); });
    SEAM(0);
    RUNPH(1, {
        fft1_phase(c, WSP(bf16_t, WS_HT), WSP(float, WS_TW), WSP(bf16_t, WS_Y2));
        GBAR();
        fft2_phase(c, WSP(bf16_t, WS_Y2), WSP(bf16_t, WS_UB), WSP(bf16_t, WS_VB), WSP(bf16_t, WS_U2048));
    });
    SEAM(1);
    RUNPH(2, {
        {
            SchedRows<4> S{(const char*)(ws + WS_UB), (const char*)(ws + WS_WP), D, 256, c.G, c.v};
            EpiF32 E{WSP(bf16_t, WS_PU)};
            pg8::gemm_phase<EpiF32, SchedRows<4>, true>(c.lds, D, S, E);
        }
        asm volatile("s_waitcnt vmcnt(0)" ::: "memory"); __syncthreads();
        {
            SchedRows<4> S{(const char*)(ws + WS_VB), (const char*)(ws + WS_WP) + (size_t)D * D * 2, D, 256, c.G, c.v};
            EpiMirror E{inptr(c, 0), XRES, inptr(c, 4), WSP(bf16_t, WS_PU)};
            pg8::gemm_phase<EpiMirror, SchedRows<4>, true>(c.lds, D, S, E);
        }
        {
            const Ctx cc = refresh(c);
            const bf16_t* U2 = WSP(bf16_t, WS_U2048); const bf16_t* Wc = WSP(bf16_t, WS_WP); const float* xin = inptr(c, 0); const float* bo = inptr(c, 4); bf16_t* Xo = XRES;
            for (int it = cc.v * 8 + cc.wave; it < BATCH * D; it += cc.G * 8) {
                const int bat = it >> 10, n = it & 1023;
                const u32x4 uu0 = *((const u32x4*)(U2 + (size_t)bat * D) + cc.lane), uu1 = *((const u32x4*)(U2 + (size_t)bat * D) + 64 + cc.lane);
                const u32x4 ww0 = *((const u32x4*)(Wc + (size_t)n * D) + cc.lane), ww1 = *((const u32x4*)(Wc + (size_t)n * D) + 64 + cc.lane);
                float a = bflo(uu0.x) * bflo(ww0.x) + bfhi(uu0.x) * bfhi(ww0.x) + bflo(uu0.y) * bflo(ww0.y) + bfhi(uu0.y) * bfhi(ww0.y) + bflo(uu0.z) * bflo(ww0.z) + bfhi(uu0.z) * bfhi(ww0.z) + bflo(uu0.w) * bflo(ww0.w) + bfhi(uu0.w) * bfhi(ww0.w);
                a += bflo(uu1.x) * bflo(ww1.x) + bfhi(uu1.x) * bfhi(ww1.x) + bflo(uu1.y) * bflo(ww1.y) + bfhi(uu1.y) * bfhi(ww1.y) + bflo(uu1.z) * bflo(ww1.z) + bfhi(uu1.z) * bfhi(ww1.z) + bflo(uu1.w) * bflo(ww1.w) + bfhi(uu1.w) * bfhi(ww1.w);
                a = wave_sum(a);
                if (cc.lane == 0) { const size_t o = ((size_t)bat * SEQ + 2048) * D + n; Xo[o] = (bf16_t)f2bf(xin[o] + a + bo[n]); }
            }
        }
    });
    SEAM(2);
#undef CNT
#define CNT ((unsigned*)(ws + WS_CTL) + CW_CNT + 64 * 0)
    if (IN(3)) router_phase<F8L0>(c, XRES, inptr(c, 2) + 0 * D, inptr(c, 10) + (size_t)0 * D * NE, inptr(c, 11) + 0 * NE, WSP(unsigned char, WS_HN8), WSP(int, WS_IDX), WSP(float, WS_GATE), WSP(int, WS_RANK), CNT, WSP(int, WS_BBASE), WSP(int, WS_XS));
    SEAM(3);
    RUNPH(3 + 1, { scatter_phase(c, CNT, WSP(int, WS_IDX), WSP(int, WS_RANK), WSP(int, WS_BBASE), WSP(int, WS_SLOTOF), WSP(int, WS_XS)); });
    SEAM(3 + 1);
    RUNPH(3 + 2, {
        moe_plan(c, CNT);
        typedef SchedMoEG<8, 2048, 128, F8L0 ? 1024 : 2048> SM;
        SM S{(const char*)(ws + WS_HN8), (const char*)(ws + WS_WGU + (size_t)0 * 128 * MiB), tile_e, WSP(int, WS_XS), __builtin_amdgcn_readfirstlane(ntl[0]), c.G, c.v};
        EpiGLU<F8L0> E{WSP(unsigned char, WS_HID), inptr(c, 13) + (size_t)0 * NE * 2048};
#ifdef PROBE_ABL
        pg8::gemm_phase<EpiGLU<F8L0>, SM, true, F8L0, PROBE_ABL, true>(c.lds, F8L0 ? D / 2 : D, S, E); GBAR();
#endif
        pg8::gemm_phase<EpiGLU<F8L0>, SM, true, F8L0, 0, true>(c.lds, F8L0 ? D / 2 : D, S, E);
    });
    SEAM(3 + 2);
    RUNPH(3 + 3, {
        moe_plan(c, CNT);
        typedef SchedMoE<4, 1024, 256, true, F8L0 ? 1024 : 2048> SM;
        SM S{(const char*)(ws + WS_HID), (const char*)(ws + WS_WD + (size_t)0 * 64 * MiB), tile_e, __builtin_amdgcn_readfirstlane(ntl[0]), c.G, c.v};
        EpiBf16<1, D, F8L0, true> E{WSP(bf16_t, WS_Y), inptr(c, 15) + (size_t)0 * NE * D};
        pg8::gemm_phase<EpiBf16<1, D, F8L0, true>, SM, true, F8L0>(c.lds, F8L0 ? D / 2 : D, S, E);
    });
    SEAM(3 + 3);
    if (IN(7)) combine_phase<false>(c, XRES, WSP(bf16_t, WS_Y), WSP(float, WS_GATE), WSP(int, WS_SLOTOF), inptr(c, 1) + D, WSP(float, WS_RS), nullptr);
    SEAM(7);
    RUNPH(8, {
#ifndef NO_QK
        {
            SchedRows<5> S{(const char*)(ws + WS_XB), (const char*)(ws + WS_WQKV), D, 640, c.G, c.v};
            EpiQK E{WSP(bf16_t, WS_Q), WSP(bf16_t, WS_K), inptr(c, 6), WSP(float, WS_COS), WSP(float, WS_RS)};
            pg8::gemm_phase<EpiQK, SchedRows<5>, true>(c.lds, D, S, E);
        }
#endif
#ifndef NO_VT
        {
            SchedVT S{(const char*)(ws + WS_WQKV) + (size_t)1280 * D * 2, (const char*)(ws + WS_XB), c.G, c.v, 128};
            EpiBf16<2, T, false, false, true> E{WSP(bf16_t, WS_VT), inptr(c, 6), WSP(float, WS_RS)};
            pg8::gemm_phase<EpiBf16<2, T, false, false, true>, SchedVT, true>(c.lds, D, S, E);
        }
#endif
    });
    SEAM(8);
    RUNPH(9, { attn_phase(c, WSP(bf16_t, WS_Q), WSP(bf16_t, WS_K), WSP(bf16_t, WS_VT), inptr(c, 7), WSP(bf16_t, WS_O)); });
    SEAM(9);
    if (IN(10)) {
        SchedRows<4> S{(const char*)(ws + WS_O), (const char*)(ws + WS_WO), D, 512, c.G, c.v};
        EpiX E{XRES, XRES, inptr(c, 9)};
        pg8::gemm_phase<EpiX, SchedRows<4>, true>(c.lds, D, S, E);
    }
    SEAM(10);
#undef CNT
#define CNT ((unsigned*)(ws + WS_CTL) + CW_CNT + 64 * 1)
    if (IN(11)) router_phase<F8L1>(c, XRES, inptr(c, 2) + 1 * D, inptr(c, 10) + (size_t)1 * D * NE, inptr(c, 11) + 1 * NE, WSP(unsigned char, WS_HN8), WSP(int, WS_IDX), WSP(float, WS_GATE), WSP(int, WS_RANK), CNT, WSP(int, WS_BBASE), WSP(int, WS_XS));
    SEAM(11);
    RUNPH(11 + 1, { scatter_phase(c, CNT, WSP(int, WS_IDX), WSP(int, WS_RANK), WSP(int, WS_BBASE), WSP(int, WS_SLOTOF), WSP(int, WS_XS)); });
    SEAM(11 + 1);
    RUNPH(11 + 2, {
        moe_plan(c, CNT);
        typedef SchedMoEG<8, 2048, 128, F8L1 ? 1024 : 2048> SM;
        SM S{(const char*)(ws + WS_HN8), (const char*)(ws + WS_WGU + (size_t)1 * 128 * MiB), tile_e, WSP(int, WS_XS), __builtin_amdgcn_readfirstlane(ntl[0]), c.G, c.v};
        EpiGLU<F8L1> E{WSP(unsigned char, WS_HID), inptr(c, 13) + (size_t)1 * NE * 2048};
        pg8::gemm_phase<EpiGLU<F8L1>, SM, true, F8L1, 0, true>(c.lds, F8L1 ? D / 2 : D, S, E);
    });
    SEAM(11 + 2);
    RUNPH(11 + 3, {
        moe_plan(c, CNT);
        typedef SchedMoE<4, 1024, 256, true, F8L1 ? 1024 : 2048> SM;
        SM S{(const char*)(ws + WS_HID), (const char*)(ws + WS_WD + (size_t)1 * 64 * MiB), tile_e, __builtin_amdgcn_readfirstlane(ntl[0]), c.G, c.v};
        EpiBf16<1, D, F8L1, true> E{WSP(bf16_t, WS_Y), inptr(c, 15) + (size_t)1 * NE * D};
        pg8::gemm_phase<EpiBf16<1, D, F8L1, true>, SM, true, F8L1>(c.lds, F8L1 ? D / 2 : D, S, E);
    });
    SEAM(11 + 3);
    if (IN(15)) combine_phase<true>(c, XRES, WSP(bf16_t, WS_Y), WSP(float, WS_GATE), WSP(int, WS_SLOTOF), inptr(c, 16), nullptr, XOUT);
#undef IN
#undef SEAM
}

extern "C" void kernel_launch(void* const* d_in, const int* in_sizes, int n_in, void* d_out, int out_size, void* d_ws, size_t ws_size, hipStream_t stream) {
    static int grid = 0;
    if (grid == 0) {
        if (n_in != 17 || out_size != T * D || ws_size < WS_END) { fprintf(stderr, "kernel_launch: unexpected sizes n_in %d out %d ws %zu (need %zu)\n", n_in, out_size, ws_size, (size_t)WS_END); grid = -1; return; }
        int dev = 0, cus = 0, per_cu = 0;
        if (hipGetDevice(&dev) != hipSuccess || hipDeviceGetAttribute(&cus, hipDeviceAttributeMultiprocessorCount, dev) != hipSuccess) { grid = -1; return; }
        if (hipFuncSetAttribute((const void*)mk_fwd, hipFuncAttributeMaxDynamicSharedMemorySize, LDS_BYTES) != hipSuccess) { fprintf(stderr, "kernel_launch: hipFuncSetAttribute failed\n"); grid = -1; return; }
        if (hipOccupancyMaxActiveBlocksPerMultiprocessor(&per_cu, (const void*)mk_fwd, 512, LDS_BYTES) != hipSuccess || per_cu < 1) { fprintf(stderr, "kernel_launch: occupancy query says %d blocks/CU\n", per_cu); grid = -1; return; }
        (void)hipGetLastError();
        grid = cus;
    }
    if (grid < 0) return;
    (void)hipMemsetAsync((char*)d_ws + WS_CTL, 0, CTL_ZERO_BYTES, stream);
    Args a{};
    for (int i = 0; i < 17; ++i) a.in.p[i] = (const float*)d_in[i];
    a.out = (float*)d_out; a.ws = (unsigned char*)d_ws;
    if (MK_N_LAUNCHES == 1) {
        a.ph_lo = 0; a.ph_hi = NPHASE; a.li = 0;
        hipLaunchKernelGGL(mk_fwd, dim3(grid), dim3(512), LDS_BYTES, stream, a);
    } else {
        for (int li = 0; li < NPHASE; ++li) { a.ph_lo = li; a.ph_hi = li + 1; a.li = li; hipLaunchKernelGGL(mk_fwd, dim3(grid), dim3(512), LDS_BYTES, stream, a); }
    }
}
```

```cpp
#include <hip/hip_runtime.h>
#include <cstdio>
#include <cstdint>

#ifndef ST_BITS
#define ST_BITS "sc0"
#endif
#define LAS __attribute__((address_space(3)))
#define DEVI __device__ __forceinline__
typedef unsigned short bf16_t;
typedef short bf16x8 __attribute__((ext_vector_type(8)));
typedef short s16x4 __attribute__((ext_vector_type(4)));
typedef float f32x2 __attribute__((ext_vector_type(2)));
typedef float f32x4 __attribute__((ext_vector_type(4)));
typedef float f32x16 __attribute__((ext_vector_type(16)));
typedef unsigned u32x2 __attribute__((ext_vector_type(2)));
typedef unsigned u32x4 __attribute__((ext_vector_type(4)));
typedef int i32x4 __attribute__((ext_vector_type(4)));
typedef int i32x8 __attribute__((ext_vector_type(8)));
typedef __bf16 bf16x2_t __attribute__((ext_vector_type(2)));

#define PG8_BUILTIN_DMA 0
#ifndef MK_N_LAUNCHES
#define MK_N_LAUNCHES 1
#endif
constexpr int NPHASE = 16;

constexpr int D = 1024, BATCH = 8, SEQ = 4096, T = BATCH * SEQ, NE = 32, TOPK = 4, QKVD = 1536, NH = 16;
constexpr int MT = 256, NSLOT = T * TOPK + NE * MT, NTILE = NSLOT / MT;
constexpr float RMS_EPS = 1e-5f;

constexpr size_t MiB = 1u << 20;
constexpr size_t WS_CTL = 0, CTL_ZERO_BYTES = 128 * 1024;
constexpr size_t WS_WGU = 2 * MiB;
constexpr size_t WS_WD = WS_WGU + 256 * MiB;
constexpr size_t WS_WP = WS_WD + 128 * MiB;
constexpr size_t WS_WQKV = WS_WP + 4 * MiB;
constexpr size_t WS_WO = WS_WQKV + 3 * MiB;
constexpr size_t WS_CS = WS_WO + 3 * MiB;
constexpr size_t WS_XB = WS_CS;
constexpr size_t WS_HT = WS_CS + 64 * MiB;
constexpr size_t WS_A2 = WS_HT + 64 * MiB;
constexpr size_t WS_UB = WS_A2, WS_VB = WS_A2 + 32 * MiB, WS_U2048 = WS_A2 + 64 * MiB;
constexpr size_t WS_HN = WS_A2 + 128 * MiB;
constexpr size_t WS_HN8 = WS_HN + 64 * MiB;
constexpr size_t WS_XS = WS_HN8 + 64 * MiB;
constexpr int ETOK_E = 32768;
constexpr size_t WS_HID = WS_XS + 272 * MiB;
constexpr size_t WS_Y = WS_HID + 272 * MiB;
constexpr size_t WS_Q = WS_Y + 272 * MiB;
constexpr size_t WS_K = WS_Q + 64 * MiB;
constexpr size_t WS_VT = WS_K + 16 * MiB;
constexpr size_t WS_O = WS_VT + 16 * MiB;
constexpr size_t WS_IDX = WS_O + 64 * MiB;
constexpr size_t WS_GATE = WS_IDX + 1 * MiB;
constexpr size_t WS_RANK = WS_GATE + 1 * MiB;
constexpr size_t WS_SLOTOF = WS_RANK + 1 * MiB;
constexpr size_t WS_BBASE = WS_SLOTOF + 1 * MiB;
constexpr size_t WS_COS = WS_BBASE + 1 * MiB;
constexpr size_t WS_SIN = WS_COS + 1 * MiB;
constexpr size_t WS_TW = WS_SIN + 512 * 1024;
constexpr size_t WS_RS = WS_TW + 64 * 1024;
constexpr size_t WS_PU = WS_Y + 128 * MiB;
constexpr size_t WS_Y2 = WS_Y;
constexpr size_t WS_END = WS_SIN + 1 * MiB;
constexpr bool F8L0 = true, F8L1 = true;
constexpr float WSCALE = 32.0f, WINV = 1.0f / 32.0f;
constexpr int CW_BAR = 4096, CW_CNT = 16384;

constexpr int RING_BYTES = 131072;
constexpr int LDSCTL_OFF = 135168;
constexpr int LC_BARST = 0;
constexpr int LC_HIST = 64;
constexpr int LC_PST = 256;
constexpr int LC_NT = 384;
constexpr int LC_PTRS = 512;
constexpr int LC_PRE = 6144;
constexpr int LC_GTOK = 8192;
constexpr int LC_TILEE = 1024;
constexpr int LDS_BYTES = 147456;
static_assert(LDSCTL_OFF + LC_TILEE + NTILE * 4 <= LDS_BYTES, "LDS map");

#define RLX_AGENT __ATOMIC_RELAXED, __HIP_MEMORY_SCOPE_AGENT
DEVI unsigned f2bf(float f) { unsigned u = __builtin_bit_cast(unsigned, f); return (u + 0x7fffu + ((u >> 16) & 1u)) >> 16; }
DEVI unsigned pk2(float lo, float hi) { f32x2 v = {lo, hi}; bf16x2_t b = __builtin_convertvector(v, bf16x2_t); return __builtin_bit_cast(unsigned, b); }
DEVI unsigned pk4f8(float a, float b, float c, float d) { int w = 0; w = __builtin_amdgcn_cvt_pk_fp8_f32(a, b, w, false); w = __builtin_amdgcn_cvt_pk_fp8_f32(c, d, w, true); return (unsigned)w; }
DEVI float bflo(unsigned w) { return __builtin_bit_cast(float, w << 16); }
DEVI float bfhi(unsigned w) { return __builtin_bit_cast(float, w & 0xffff0000u); }
DEVI int opaque_tid();
template <int O> DEVI unsigned xor_u32(unsigned v, bool) {
    if constexpr (O < 32) return (unsigned)__builtin_amdgcn_ds_swizzle((int)v, (O << 10) | 0x1F);
    else return (unsigned)__builtin_amdgcn_ds_bpermute(((opaque_tid() ^ 32) & 63) << 2, (int)v);
}
template <int O> DEVI float xor_f32(float v, bool hi32) { return __builtin_bit_cast(float, xor_u32<O>(__builtin_bit_cast(unsigned, v), hi32)); }
DEVI float sum32(float v) { return v + xor_f32<32>(v, false); }
DEVI float max32(float v) { return fmaxf(v, xor_f32<32>(v, false)); }
DEVI float wave_sum(float v) {
    v += xor_f32<1>(v, false); v += xor_f32<2>(v, false); v += xor_f32<4>(v, false); v += xor_f32<8>(v, false); v += xor_f32<16>(v, false);
    return sum32(v);
}
DEVI int opaque_tid() { int t = threadIdx.x; asm volatile("" : "+v"(t)); return t; }

namespace pg8 {
constexpr int BM = 256, BK = 64, HALF = 128, HTB = HALF * BK * 2, STAGE_BYTES = 8 * HTB;
DEVI int lds_byte(int r, int c) { const int st = (r >> 4) * 2 + (c >> 5), rr = r & 15, cc = c & 31, ob = rr * 64 + cc * 2; return st * 1024 + (ob ^ (((ob >> 9) & 1) << 5)); }
DEVI void stage_rc(int b, int& R, int& C) { const int st = b / 1024, sb = b % 1024, swz = sb ^ (((sb >> 9) & 1) << 5); R = (st >> 1) * 16 + swz / 64; C = (st & 1) * 32 + (swz % 64) / 2; }
DEVI int perm32(int rho) { const int n = rho >> 4, i = rho & 15; return 8 * (i >> 2) + 4 * n + (i & 3); }

struct Unit { const char* a; const char* b; int orow, ocol, aux; };

template <class Epi, class Sched, bool ALIGN_EPI, bool FP8 = false, int ABL = 0  , bool GATHER = false, bool ABLK = false>
DEVI void gemm_phase(LAS unsigned char* lds, const int K, const Sched& S, const Epi& E) {
    const int tid = opaque_tid(), wid = __builtin_amdgcn_readfirstlane(tid >> 6), lane = tid & 63, wr = wid >> 2, wc = wid & 3, fr = lane & 15, fq = lane >> 4;
    const int nt = K / BK;
    constexpr int PM = (int)Epi::PERM;
    unsigned voffA[2], voffB[2], gidx = 0, gcol = 0;
#pragma unroll
    for (int i = 0; i < 2; ++i) { int R, C; stage_rc(tid * 16 + i * 8192, R, C); const int Rb = PM == 2 ? (64 * (R >> 5) + 16 * ((R >> 2) & 3) + 4 * ((R >> 4) & 1) + (R & 3)) : PM == 1 ? ((R & ~31) + perm32(R & 31)) : R;
        voffA[i] = ABLK ? (unsigned)((R >> 4) * 2048 + ((C * 2) >> 5) * 512 + (R & 15) * 32 + ((C * 2) & 31)) : (unsigned)(R * K + C) * 2u; voffB[i] = (unsigned)(Rb * K + C) * 2u; if (i == 0) { gidx = (unsigned)R; gcol = (unsigned)C * 2u; } }
    unsigned gvo[2] = {0u, 0u}, gnx[2] = {0u, 0u};
    const size_t kstep = (size_t)(BK * 2);
    const int rot = S.rot() & (nt - 1);
#define PG8_KO(lt) ((size_t)(((lt) + rot) & (nt - 1)) * kstep)
#define PG8_KOA(lt) ((size_t)(((lt) + rot) & (nt - 1)) * kstepA)
    const size_t hstep = (size_t)HALF * K * 2;
    const size_t kstepA = ABLK ? (size_t)32768 : kstep, hstepA = ABLK ? (size_t)16384 : hstep;
    const size_t hstepB = PM == 2 ? (size_t)8 * K * 2 : hstep;
    const unsigned ldsw = (unsigned)wid * 1024u;
    const unsigned ptabb = __builtin_amdgcn_readfirstlane((unsigned)(unsigned long long)lds) + (unsigned)(LDSCTL_OFF + LC_PRE);
    const unsigned gtab = __builtin_amdgcn_readfirstlane((unsigned)(unsigned long long)lds) + (unsigned)(LDSCTL_OFF + LC_GTOK);
    const unsigned ldsb = __builtin_amdgcn_readfirstlane((unsigned)(unsigned long long)lds) + ldsw;
    const int aoff = lds_byte(wr * 64 + fr, fq * 8), boff = lds_byte(wc * 32 + fr, fq * 8);
#define PG8_SA(b, h) (((b) * 2 + (h)) * HTB)
#define PG8_SB(b, h) ((4 + (b) * 2 + (h)) * HTB)
#if PG8_BUILTIN_DMA
#define PG8_STAGE(bufoff, gbase, voff) do { _Pragma("unroll") for (int _i = 0; _i < 2; ++_i) \
        __builtin_amdgcn_global_load_lds((const unsigned*)((const char*)(gbase) + (voff)[_i]), (LAS unsigned*)(lds + (bufoff) + ldsw + _i * 8192), 16, 0, 0); } while (0)
#else
#define PG8_STAGE(bufoff, gbase, voff) do { _Pragma("unroll") for (int _i = 0; _i < 2; ++_i) { unsigned keep_; \
        asm volatile("s_mov_b32 %0, m0\n\ts_mov_b32 m0, %3\n\ts_nop 0\n\tglobal_load_lds_dwordx4 %1, %2\n\ts_mov_b32 m0, %0" : "=&s"(keep_) : "v"((voff)[_i]), "s"((const char*)(gbase)), "s"(ldsb + (unsigned)((bufoff) + _i * 8192)) : "memory"); } } while (0)
#endif
#define PG8_GLOAD(bufi, u_) do { if constexpr (GATHER) { if (wid < 4) { unsigned keep_; \
        asm volatile("s_mov_b32 %0, m0\n\ts_mov_b32 m0, %3\n\ts_nop 0\n\tglobal_load_lds_dword %1, %2\n\ts_mov_b32 m0, %0" : "=&s"(keep_) \
            : "v"((unsigned)(S.goff(u_) * 4) + (unsigned)((opaque_tid() & 255) * 4)), "s"((const char*)S.slot_tok), "s"(gtab + (unsigned)((bufi) * 1024) + (unsigned)(wid * 256)) : "memory"); } } } while (0)
#define PG8_GOFF(dst, h, bufsel) do { if constexpr (GATHER) { const LAS unsigned* tp_ = (const LAS unsigned*)(lds + LDSCTL_OFF + LC_GTOK) + (gidx + (unsigned)(((bufsel) & 1) * 256));   \
        dst[0] = tp_[(h) * 128] * (unsigned)(K * 2) + gcol; dst[1] = tp_[(h) * 128 + 64] * (unsigned)(K * 2) + gcol; } } while (0)
#define PG8_GNEXT() do { if constexpr (GATHER) { gvo[0] = gnx[0]; gvo[1] = gnx[1]; } } while (0)
#define PG8_STAGE_A(bufoff, base, h) do { if constexpr (GATHER) { PG8_STAGE(bufoff, base, gvo); } else PG8_STAGE(bufoff, (base) + (h) * hstepA, voffA); } while (0)
#define PG8_LDA(dst, b, h) do { _Pragma("unroll") for (int m = 0; m < 4; ++m) _Pragma("unroll") for (int k = 0; k < 2; ++k) dst[m][k] = *(const LAS bf16x8*)(lds + PG8_SA(b, h) + aoff + m * 2048 + k * 1024); } while (0)
#define PG8_LDB(dst, b, h) do { _Pragma("unroll") for (int n = 0; n < 2; ++n) _Pragma("unroll") for (int k = 0; k < 2; ++k) dst[n][k] = *(const LAS bf16x8*)(lds + PG8_SB(b, h) + boff + n * 2048 + k * 1024); } while (0)
#define PG8_CAT(x) __builtin_shufflevector(__builtin_bit_cast(i32x4, (x)[0]), __builtin_bit_cast(i32x4, (x)[1]), 0, 1, 2, 3, 4, 5, 6, 7)
#define PG8_MMAZ(ai, bj, At, Bt, Z) do { if constexpr (ABL == 2) { asm volatile("" :: "v"(At[0][0]), "v"(At[3][1]), "v"(Bt[0][0]), "v"(Bt[1][1])); break; } __builtin_amdgcn_s_setprio(1); _Pragma("unroll") for (int m = 0; m < 4; ++m) _Pragma("unroll") for (int n = 0; n < 2; ++n) { \
        if constexpr (FP8) acc[ai][bj][m][n] = __builtin_amdgcn_mfma_scale_f32_16x16x128_f8f6f4(PG8_CAT(Bt[n]), PG8_CAT(At[m]), (Z) ? (f32x4){0.f, 0.f, 0.f, 0.f} : acc[ai][bj][m][n], 0, 0, 0, 0, 0, 0); \
        else { acc[ai][bj][m][n] = __builtin_amdgcn_mfma_f32_16x16x32_bf16(Bt[n][0], At[m][0], (Z) ? (f32x4){0.f, 0.f, 0.f, 0.f} : acc[ai][bj][m][n], 0, 0, 0); acc[ai][bj][m][n] = __builtin_amdgcn_mfma_f32_16x16x32_bf16(Bt[n][1], At[m][1], acc[ai][bj][m][n], 0, 0, 0); } } __builtin_amdgcn_s_setprio(0); } while (0)
#define PG8_MMA(ai, bj, At, Bt) PG8_MMAZ(ai, bj, At, Bt, false)
#define PG8_WAIT_V(n) asm volatile("s_waitcnt vmcnt(" #n ")" ::: "memory")
#define PG8_WAIT_L(n) asm volatile("s_waitcnt lgkmcnt(" #n ")" ::: "memory")
#define PG8_BAR __builtin_amdgcn_s_barrier()
#define PG8_SCHED __builtin_amdgcn_sched_barrier(0)
    Unit cur, nxt; int ui = 0;
    if (!S.next(0, cur)) return;
    f32x4 acc[2][2][4][2];
    if constexpr (ABL != 0) { _Pragma("unroll") for (int a = 0; a < 2; ++a) _Pragma("unroll") for (int b = 0; b < 2; ++b) _Pragma("unroll") for (int m = 0; m < 4; ++m) _Pragma("unroll") for (int n = 0; n < 2; ++n) acc[a][b][m][n] = (f32x4){0.f, 0.f, 0.f, 0.f}; }
    bf16x8 At[4][2], B0[2][2], B1[2][2];
    const char* cA = cur.a; const char* cB = cur.b;
    if constexpr (GATHER) { PG8_GLOAD(0, cur); asm volatile("s_waitcnt vmcnt(0)" ::: "memory"); __builtin_amdgcn_s_barrier(); asm volatile("" ::: "memory"); }
    PG8_STAGE(PG8_SB(0, 0), cB + PG8_KO(0), voffB); PG8_STAGE(PG8_SB(0, 1), cB + hstepB + PG8_KO(0), voffB); PG8_GOFF(gvo, 0, 0); PG8_STAGE_A(PG8_SA(0, 0), cA + PG8_KOA(0), 0); PG8_GOFF(gvo, 1, 0); PG8_STAGE_A(PG8_SA(0, 1), cA + PG8_KOA(0), 1);
    if (wr == 1) PG8_BAR;
    PG8_WAIT_V(2); PG8_BAR;
    PG8_STAGE(PG8_SB(1, 0), cB + PG8_KO(1), voffB); PG8_GOFF(gvo, 0, 0); PG8_STAGE_A(PG8_SA(1, 0), cA + PG8_KOA(1), 0); PG8_STAGE(PG8_SB(1, 1), cB + hstepB + PG8_KO(1), voffB);
    PG8_WAIT_V(6); PG8_BAR;
    for (;;) {
        const bool has_next = S.next(ui + 1, nxt);
        const char* nA = has_next ? nxt.a : cA; const char* nB = has_next ? nxt.b : cB;
        if (has_next) PG8_GLOAD((ui + 1) & 1, nxt);
        PG8_GOFF(gnx, 1, ui);
        if constexpr (Epi::PRE) { if (wid < 4) { unsigned keep_;
            asm volatile("s_mov_b32 %0, m0\n\ts_mov_b32 m0, %3\n\ts_nop 0\n\tglobal_load_lds_dword %1, %2\n\ts_mov_b32 m0, %0" : "=&s"(keep_)
                : "v"(E.pre_off(cur, (opaque_tid() & 255))), "s"(E.pre_base()), "s"(ptabb + (unsigned)((ui & 1) * 1024) + (unsigned)(wid * 256)) : "memory"); } }
#define PG8_TRIP(t, Z) { \
            const bool last = ((t) == nt - 2); \
            const char* a1 = cA + PG8_KOA((t) + 1); \
            const size_t ko2 = PG8_KO(last ? 0 : (t) + 2), ko3 = PG8_KO(last ? 1 : (t) + 3); \
            const char* a2 = (last ? nA : cA) + (ABLK ? PG8_KOA(last ? 0 : (t) + 2) : ko2); const char* b2 = (last ? nB : cB) + ko2; \
            const char* a3 = (last ? nA : cA) + (ABLK ? PG8_KOA(last ? 1 : (t) + 3) : ko3); const char* b3 = (last ? nB : cB) + ko3; \
            const int nb_ = (last && has_next) ? ui + 1 : ui;         \
            PG8_GNEXT(); PG8_LDB(B0, 0, 0); PG8_LDB(B1, 0, 1); PG8_SCHED; PG8_LDA(At, 0, 0); PG8_GOFF(gnx, 0, nb_); PG8_STAGE_A(PG8_SA(1, 1), a1, 1); \
            PG8_WAIT_V(8); PG8_WAIT_L(0); PG8_BAR; PG8_MMAZ(0, 0, At, B0, Z); PG8_MMAZ(0, 1, At, B1, Z); PG8_BAR; PG8_SCHED; \
            PG8_GNEXT(); PG8_LDA(At, 0, 1); PG8_GOFF(gnx, 1, nb_); PG8_STAGE(PG8_SB(0, 0), b2, voffB); PG8_STAGE(PG8_SB(0, 1), b2 + hstepB, voffB); PG8_STAGE_A(PG8_SA(0, 0), a2, 0); \
            PG8_WAIT_V(8); PG8_WAIT_L(0); PG8_BAR; PG8_MMAZ(1, 0, At, B0, Z); PG8_MMAZ(1, 1, At, B1, Z); PG8_BAR; PG8_SCHED; \
            PG8_GNEXT(); PG8_LDB(B0, 1, 0); PG8_LDB(B1, 1, 1); PG8_SCHED; PG8_LDA(At, 1, 0); PG8_GOFF(gnx, 0, nb_); PG8_STAGE_A(PG8_SA(0, 1), a2, 1); \
            PG8_WAIT_V(8); PG8_WAIT_L(0); PG8_BAR; PG8_MMA(0, 0, At, B0); PG8_MMA(0, 1, At, B1); PG8_BAR; PG8_SCHED; \
            PG8_GNEXT(); PG8_LDA(At, 1, 1); if (!last) PG8_GOFF(gnx, 1, nb_); PG8_STAGE(PG8_SB(1, 0), b3, voffB); PG8_STAGE(PG8_SB(1, 1), b3 + hstepB, voffB); PG8_STAGE_A(PG8_SA(1, 0), a3, 0); \
            PG8_WAIT_V(8); PG8_WAIT_L(0); PG8_BAR; PG8_MMA(1, 0, At, B0); PG8_MMA(1, 1, At, B1); PG8_BAR; PG8_SCHED; }
        PG8_TRIP(0, true)
#pragma unroll 1
        for (int t = 2; t < nt; t += 2) PG8_TRIP(t, false)
#undef PG8_TRIP
        if constexpr (ALIGN_EPI) { if (wr == 0) PG8_BAR; }
        if constexpr (ABL == 0) E(acc, cur, (const LAS float*)(lds + LDSCTL_OFF + LC_PRE + (ui & 1) * 1024)); else { _Pragma("unroll") for (int a_ = 0; a_ < 2; ++a_) _Pragma("unroll") for (int b_ = 0; b_ < 2; ++b_) _Pragma("unroll") for (int m_ = 0; m_ < 4; ++m_) _Pragma("unroll") for (int n_ = 0; n_ < 2; ++n_) asm volatile("" :: "v"(acc[a_][b_][m_][n_])); }
        if (!has_next) break;
        cur = nxt; cA = nA; cB = nB; ++ui;
        if constexpr (ALIGN_EPI) { if (wr == 1) PG8_BAR; }
    }
    PG8_WAIT_V(0);
    if constexpr (!ALIGN_EPI) { if (wr == 0) PG8_BAR; }
    PG8_BAR;
#undef PG8_KO
#undef PG8_KOA
#undef PG8_SA
#undef PG8_SB
#undef PG8_STAGE
#undef PG8_STAGE_A
#undef PG8_GLOAD
#undef PG8_GOFF
#undef PG8_GNEXT
#undef PG8_LDA
#undef PG8_LDB
#undef PG8_MMA
#undef PG8_MMAZ
#undef PG8_CAT
#undef PG8_WAIT_V
#undef PG8_WAIT_L
#undef PG8_BAR
#undef PG8_SCHED
}
}
using pg8::Unit;
typedef f32x4 Acc[2][2][4][2];

template <int BIAS  , int LDC, bool S32 = false  , bool O8 = false  , bool CSC = false  >
struct EpiBf16 {
    static constexpr int PERM = O8 ? 2 : 1;
    static constexpr bool PRE = (BIAS == 1);
    DEVI const char* pre_base() const { return (const char*)bias; }
    DEVI unsigned pre_off(const Unit& u, int f) const { const int q = f >> 4, i = f & 15; return (unsigned)(u.aux + (O8 ? (q >> 2) * 64 + (q & 3) * 16 + i : (q >> 2) * 32 + (q & 3) * 8 + (i & 7) + 128 * (i >> 3))) * 4u; }
    bf16_t* O; const float* bias; const float* csc;
    DEVI void operator()(const Acc& acc, const Unit& u, const LAS float* ptab) const {
        const int tid_ = opaque_tid(), wid_ = tid_ >> 6, wr = wid_ >> 2, wc = wid_ & 3, fr = tid_ & 15, fq = (tid_ & 63) >> 4;
        const int lc = wc * 32 + 8 * fq;
        f32x4 cs[2][2];
        if (CSC) {
#pragma unroll
            for (int bj = 0; bj < 2; ++bj)
#pragma unroll
                for (int n = 0; n < 2; ++n) cs[bj][n] = *(const f32x4*)(csc + u.ocol + lc + bj * 128 + 4 * n); }
        bf16_t* base = O + (size_t)(u.orow + wr * 64 + fr) * LDC + u.ocol + lc;
        const float* bp = bias + u.aux + (BIAS == 1 ? lc : wr * 64 + fr);
        f32x4 bc[2][2];
        if (BIAS == 1) { const LAS f32x4* tb = (const LAS f32x4*)(ptab + (wc * 4 + fq) * 16); bc[0][0] = tb[0]; bc[0][1] = tb[1]; bc[1][0] = tb[2]; bc[1][1] = tb[3]; }
#pragma unroll
        for (int ai = 0; ai < 2; ++ai)
#pragma unroll
            for (int m = 0; m < 4; ++m) {
                bf16_t* rowp = base + (size_t)(ai * 128 + m * 16) * LDC;
                float br = 0.f; if (BIAS == 2) br = bp[ai * 128 + m * 16];
                u32x4 w8;
#pragma unroll
                for (int bj = 0; bj < 2; ++bj) {
                    f32x4 v0 = acc[ai][bj][m][0], v1 = acc[ai][bj][m][1];
                    if (S32) { v0 *= WINV; v1 *= WINV; }
                    if (CSC) { v0 *= cs[bj][0]; v1 *= cs[bj][1]; }
                    if (BIAS == 1) { v0 += bc[bj][0]; v1 += bc[bj][1]; }
                    if (BIAS == 2) { v0 += br; v1 += br; }
                    if (O8) { w8[2 * bj] = pk4f8(v0[0], v0[1], v0[2], v0[3]); w8[2 * bj + 1] = pk4f8(v1[0], v1[1], v1[2], v1[3]); }
                    else { u32x4 w; w.x = pk2(v0[0], v0[1]); w.y = pk2(v0[2], v0[3]); w.z = pk2(v1[0], v1[1]); w.w = pk2(v1[2], v1[3]);
                    *(u32x4*)(rowp + bj * 128) = w; }
                }
                if (O8) { unsigned char* sp_ = (unsigned char*)O + ((size_t)(u.orow + wr * 64 + fr + ai * 128 + m * 16) * LDC + u.ocol + wc * 64 + 16 * fq); asm volatile("global_store_dwordx4 %0, %1, off " ST_BITS "\n\ts_nop 1" :: "v"(sp_), "v"(w8) : "memory"); }
                asm volatile("" ::: "memory");
            }
    }
};
template <bool S32 = false>
struct EpiX {
    static constexpr bool PERM = true;
    static constexpr bool PRE = true;
    DEVI const char* pre_base() const { return (const char*)bias; }
    DEVI unsigned pre_off(const Unit& u, int f) const { const int q = f >> 4, i = f & 15; return (unsigned)(u.ocol + (q >> 2) * 32 + (q & 3) * 8 + (i & 7) + 128 * (i >> 3)) * 4u; }
    const bf16_t* R; bf16_t* X; const float* bias;
    DEVI void operator()(const Acc& acc, const Unit& u, const LAS float* ptab) const {
        const int tid_ = opaque_tid(), wid_ = tid_ >> 6, wr = wid_ >> 2, wc = wid_ & 3, fr = tid_ & 15, fq = (tid_ & 63) >> 4;
        const int col0 = u.ocol + wc * 32 + 8 * fq;
        const LAS f32x4* tb = (const LAS f32x4*)(ptab + (wc * 4 + fq) * 16);
        const size_t off0 = (size_t)(u.orow + wr * 64 + fr) * D + col0;
        u32x4 rc[2], rn[2];
#pragma unroll
        for (int bj = 0; bj < 2; ++bj) rc[bj] = *(const u32x4*)(R + off0 + bj * 128);
#pragma unroll
        for (int it = 0; it < 8; ++it) {
            const int ai = it >> 2, m = it & 3;
            const size_t off = off0 + (size_t)(ai * 128 + m * 16) * D;
            if (it < 7) { const size_t offn = off0 + (size_t)(((it + 1) >> 2) * 128 + ((it + 1) & 3) * 16) * D;
#pragma unroll
                for (int bj = 0; bj < 2; ++bj) rn[bj] = *(const u32x4*)(R + offn + bj * 128); }
#pragma unroll
            for (int bj = 0; bj < 2; ++bj) {
                const u32x4 rw = rc[bj];
                const f32x4 v0 = (f32x4){bflo(rw.x), bfhi(rw.x), bflo(rw.y), bfhi(rw.y)} + acc[ai][bj][m][0] * (S32 ? WINV : 1.0f) + tb[2 * bj], v1 = (f32x4){bflo(rw.z), bfhi(rw.z), bflo(rw.w), bfhi(rw.w)} + acc[ai][bj][m][1] * (S32 ? WINV : 1.0f) + tb[2 * bj + 1];
                u32x4 w; w.x = pk2(v0[0], v0[1]); w.y = pk2(v0[2], v0[3]); w.z = pk2(v1[0], v1[1]); w.w = pk2(v1[2], v1[3]);
                *(u32x4*)(X + off + bj * 128) = w;
            }
#pragma unroll
            for (int bj = 0; bj < 2; ++bj) rc[bj] = rn[bj];
            asm volatile("" ::: "memory");
        }
    }
};
struct EpiF32 {
    static constexpr bool PERM = true;
    static constexpr bool PRE = false;
    bf16_t* C;
    DEVI void operator()(const Acc& acc, const Unit& u, const LAS float* ptab) const {
        const int tid_ = opaque_tid(), wid_ = tid_ >> 6, wr = wid_ >> 2, wc = wid_ & 3, fr = tid_ & 15, fq = (tid_ & 63) >> 4;
        bf16_t* base = C + (size_t)(u.orow + wr * 64 + fr) * D + u.ocol + wc * 32 + 8 * fq;
#pragma unroll
        for (int ai = 0; ai < 2; ++ai)
#pragma unroll
            for (int m = 0; m < 4; ++m)
#pragma unroll
                for (int bj = 0; bj < 2; ++bj) { const f32x4 v0 = acc[ai][bj][m][0], v1 = acc[ai][bj][m][1];
                    u32x4 w; w.x = pk2(v0[0], v0[1]); w.y = pk2(v0[2], v0[3]); w.z = pk2(v1[0], v1[1]); w.w = pk2(v1[2], v1[3]);
                    *(u32x4*)(base + (size_t)(ai * 128 + m * 16) * D + bj * 128) = w; }
    }
};
struct EpiMirror {
    static constexpr bool PERM = true;
    static constexpr bool PRE = false;
    const float* R; bf16_t* X; const float* bias; const bf16_t* PU;
    DEVI void operator()(const Acc& acc, const Unit& u, const LAS float* ptab) const {
        const int tid_ = opaque_tid(), wid_ = tid_ >> 6, wr = wid_ >> 2, wc = wid_ & 3, fr = tid_ & 15, fq = (tid_ & 63) >> 4;
        const int col0 = u.ocol + wc * 32 + 8 * fq;
        const int r0 = u.orow + wr * 64 + fr;
        const int bat = r0 >> 11, sp0 = r0 & 2047;
        const float* x1p = R + ((size_t)bat * SEQ + sp0) * D + col0; bf16_t* y1p = X + ((size_t)bat * SEQ + sp0) * D + col0;
        const bf16_t* pup = PU + (size_t)r0 * D + col0;
        f32x4 bv[2][2];
#pragma unroll
        for (int bj = 0; bj < 2; ++bj)
#pragma unroll
            for (int n = 0; n < 2; ++n) bv[bj][n] = *(const f32x4*)(bias + col0 + bj * 128 + n * 4);
        u32x4 pc, pn; f32x4 ac[2], bc2[2], an[2], bn[2];
#define EM_LOAD(P_, A_, B_, st_) { const int ro_ = ((st_) >> 3) * 128 + (((st_) >> 1) & 3) * 16, co_ = ((st_) & 1) * 128, spn_ = sp0 + ro_; \
        const float* x2p_ = R + ((size_t)bat * SEQ + ((SEQ - spn_) & (SEQ - 1))) * D + col0 + co_; \
        P_ = __builtin_nontemporal_load((const u32x4*)(pup + (size_t)ro_ * D + co_)); \
        _Pragma("unroll") for (int n = 0; n < 2; ++n) { A_[n] = *(const f32x4*)(x1p + (size_t)ro_ * D + co_ + n * 4); B_[n] = *(const f32x4*)(x2p_ + n * 4); } }
        EM_LOAD(pc, ac, bc2, 0)
#pragma unroll
        for (int st = 0; st < 16; ++st) {
            const int ai = st >> 3, m = (st >> 1) & 3, bj = st & 1, ro = ai * 128 + m * 16, co = bj * 128, sp = sp0 + ro;
            if (st < 15) EM_LOAD(pn, an, bn, st + 1)
            bf16_t* x2o = X + ((size_t)bat * SEQ + ((SEQ - sp) & (SEQ - 1))) * D + col0 + co;
            const f32x4 pu0 = (f32x4){bflo(pc.x), bfhi(pc.x), bflo(pc.y), bfhi(pc.y)} + bv[bj][0], pu1 = (f32x4){bflo(pc.z), bfhi(pc.z), bflo(pc.w), bfhi(pc.w)} + bv[bj][1];
            { const f32x4 o0 = ac[0] + pu0 + acc[ai][bj][m][0], o1 = ac[1] + pu1 + acc[ai][bj][m][1];
              u32x4 w; w.x = pk2(o0[0], o0[1]); w.y = pk2(o0[2], o0[3]); w.z = pk2(o1[0], o1[1]); w.w = pk2(o1[2], o1[3]); *(u32x4*)(y1p + (size_t)ro * D + co) = w; }
            if (sp != 0) { const f32x4 o0 = bc2[0] + pu0 - acc[ai][bj][m][0], o1 = bc2[1] + pu1 - acc[ai][bj][m][1];
              u32x4 w; w.x = pk2(o0[0], o0[1]); w.y = pk2(o0[2], o0[3]); w.z = pk2(o1[0], o1[1]); w.w = pk2(o1[2], o1[3]); *(u32x4*)x2o = w; }
            pc = pn;
#pragma unroll
            for (int n = 0; n < 2; ++n) { ac[n] = an[n]; bc2[n] = bn[n]; }
            asm volatile("" ::: "memory");
        }
#undef EM_LOAD
    }
};
template <bool F8>
struct EpiGLU {
    static constexpr bool PERM = true;
    static constexpr bool PRE = true;
    DEVI const char* pre_base() const { return (const char*)bgu; }
    DEVI unsigned pre_off(const Unit& u, int f) const { const int q = f >> 4, i = f & 15; return (unsigned)(u.aux * 2048 + u.ocol + (q >> 2) * 32 + (q & 3) * 8 + (i & 7) + 1024 * (i >> 3)) * 4u; }
    unsigned char* HID; const float* bgu;
    DEVI void operator()(const Acc& acc, const Unit& u, const LAS float* ptab) const {
        const int tid_ = opaque_tid(), wid_ = tid_ >> 6, wr = wid_ >> 2, wc = wid_ & 3, fr = tid_ & 15, fq = (tid_ & 63) >> 4;
        const int lc = wc * 32 + 8 * fq;
        const LAS f32x4* tb = (const LAS f32x4*)(ptab + (wc * 4 + fq) * 16);
        const f32x4 g0 = tb[0], g1 = tb[1], u0 = tb[2], u1 = tb[3];
        constexpr int EB = F8 ? 1 : 2; constexpr float SC = F8 ? WINV : 1.0f;
        unsigned char* base = F8 ? HID + (size_t)(u.orow >> 8) * 262144 + (size_t)(u.ocol >> 7) * 32768 + (wr * 4) * 2048 + wc * 512 + fr * 32 + 8 * fq : HID + ((size_t)(u.orow + wr * 64 + fr) * D + u.ocol + lc) * EB;
        const bool oddq = (fq & 1) != 0;
#pragma unroll
        for (int ai = 0; ai < 2; ++ai)
#pragma unroll
            for (int mp = 0; mp < 4; mp += (F8 ? 2 : 1)) {
                u32x2 wm[2];
#pragma unroll
                for (int mm = 0; mm < (F8 ? 2 : 1); ++mm) {
                    const int m = mp + mm;
                    float o[8];
#pragma unroll
                    for (int n = 0; n < 2; ++n)
#pragma unroll
                        for (int j = 0; j < 4; j += 2) {
                            const f32x4 bgv = n ? g1 : g0, buv = n ? u1 : u0;
                            f32x2 g = (f32x2){acc[ai][0][m][n][j], acc[ai][0][m][n][j + 1]} * SC + (f32x2){bgv[j], bgv[j + 1]};
                            f32x2 up = (f32x2){acc[ai][1][m][n][j], acc[ai][1][m][n][j + 1]} * SC + (f32x2){buv[j], buv[j + 1]};
                            g.x = fminf(g.x, 7.0f); g.y = fminf(g.y, 7.0f);
                            up.x = __builtin_amdgcn_fmed3f(up.x, -7.0f, 7.0f); up.y = __builtin_amdgcn_fmed3f(up.y, -7.0f, 7.0f);
                            f32x2 e = g * (-1.702f * 1.4426950408889634f);
                            e.x = __builtin_amdgcn_exp2f(e.x); e.y = __builtin_amdgcn_exp2f(e.y);
                            const f32x2 d = e + 1.0f;
                            f32x2 r; r.x = __builtin_amdgcn_rcpf(d.x); r.y = __builtin_amdgcn_rcpf(d.y);
                            const f32x2 glu = g * r, ov = up * glu + glu;
                            o[n * 4 + j] = ov.x; o[n * 4 + j + 1] = ov.y;
                        }
                    if (F8) { wm[mm].x = pk4f8(o[0], o[1], o[2], o[3]); wm[mm].y = pk4f8(o[4], o[5], o[6], o[7]); }
                    else { unsigned char* dp = base + (size_t)(ai * 128 + m * 16) * D * EB; u32x4 w; w.x = pk2(o[0], o[1]); w.y = pk2(o[2], o[3]); w.z = pk2(o[4], o[5]); w.w = pk2(o[6], o[7]); *(u32x4*)dp = w; }
                }
                if (F8) {
                    const u32x2 snd = oddq ? wm[0] : wm[1], own = oddq ? wm[1] : wm[0];
                    u32x2 rcv; rcv.x = xor_u32<16>(snd.x, false); rcv.y = xor_u32<16>(snd.y, false);
                    const u32x4 w16 = oddq ? (u32x4){rcv.x, rcv.y, own.x, own.y} : (u32x4){own.x, own.y, rcv.x, rcv.y};
                    unsigned char* dp = base + (size_t)(ai * 8 + mp + (oddq ? 1 : 0)) * 2048 - (oddq ? 8 : 0);
                    asm volatile("global_store_dwordx4 %0, %1, off " ST_BITS "\n\ts_nop 1" :: "v"(dp), "v"(w16) : "memory");
                }
                asm volatile("" ::: "memory");
            }
    }
};
struct EpiQK {
    static constexpr bool PERM = true;
    static constexpr bool PRE = false;
    bf16_t* Q; bf16_t* Kb; const float* bias; const float* cosT; const float* RS;
    DEVI void operator()(const Acc& acc, const Unit& u, const LAS float* ptab) const {
        const int tid_ = opaque_tid(), wid_ = tid_ >> 6, wr = wid_ >> 2, wc = wid_ & 3, fr = tid_ & 15, fq = (tid_ & 63) >> 4;
        const int pn = u.aux; const bool isq = pn < 4;
        bf16_t* base = isq ? Q + pn * 256 : Kb; const long ld = isq ? 1024 : 256; const float sc = isq ? 0.125f * 1.4426950408889634f : 1.0f;
        const int i0 = 8 * fq;
        const float* bp = bias + pn * 256 + wc * 64 + i0;
        bf16_t* rbase = base + (size_t)(u.orow + wr * 64 + fr) * ld + wc * 64 + i0;
        const int pos0 = (u.orow + wr * 64 + fr) & (SEQ - 1);
        const f32x4 bl0 = *(const f32x4*)bp, bl1 = *(const f32x4*)(bp + 4), bh0 = *(const f32x4*)(bp + 32), bh1 = *(const f32x4*)(bp + 36);
        const float* tp = cosT + pos0 * 32 + i0;
        f32x4 c0 = *(const f32x4*)tp, c1 = *(const f32x4*)(tp + 4), s0 = *(const f32x4*)(tp + 262144), s1 = *(const f32x4*)(tp + 262144 + 4), nc0, nc1, ns0, ns1;
        constexpr float rc = WINV;
#pragma unroll
        for (int it = 0; it < 8; ++it) {
            const int ai = it >> 2, m = it & 3;
            if (it < 7) { const float* tn = tp + (((it + 1) >> 2) * 128 + ((it + 1) & 3) * 16) * 32;
                nc0 = *(const f32x4*)tn; nc1 = *(const f32x4*)(tn + 4); ns0 = *(const f32x4*)(tn + 262144); ns1 = *(const f32x4*)(tn + 262144 + 4); }
            const f32x4 lo0 = acc[ai][0][m][0] * rc + bl0, lo1 = acc[ai][0][m][1] * rc + bl1, hi0 = acc[ai][1][m][0] * rc + bh0, hi1 = acc[ai][1][m][1] * rc + bh1;
            const f32x4 ol0 = (lo0 * c0 - hi0 * s0) * sc, ol1 = (lo1 * c1 - hi1 * s1) * sc;
            const f32x4 oh0 = (hi0 * c0 + lo0 * s0) * sc, oh1 = (hi1 * c1 + lo1 * s1) * sc;
            bf16_t* rowp = rbase + (size_t)(ai * 128 + m * 16) * ld;
            u32x4 w; w.x = pk2(ol0[0], ol0[1]); w.y = pk2(ol0[2], ol0[3]); w.z = pk2(ol1[0], ol1[1]); w.w = pk2(ol1[2], ol1[3]);
            *(u32x4*)rowp = w;
            w.x = pk2(oh0[0], oh0[1]); w.y = pk2(oh0[2], oh0[3]); w.z = pk2(oh1[0], oh1[1]); w.w = pk2(oh1[2], oh1[3]);
            *(u32x4*)(rowp + 32) = w;
            c0 = nc0; c1 = nc1; s0 = ns0; s1 = ns1;
            asm volatile("" ::: "memory");
        }
    }
};

struct SchedDFT {
    const char* CS; const char* HT; int G, v;
    DEVI bool next(int i, Unit& u) const {
        const int L = i * G + v; if (L >= 1024) return false;
        const int b = L >> 7, j = L & 127, pm = (j >> 5) * 8 + (j & 7), pn = (j >> 3) & 3;
        u.a = CS + (size_t)pm * 256 * SEQ * 2; u.b = HT + ((size_t)b * D + pn * 256) * SEQ * 2;
        u.orow = b * SEQ + (pm & 15) * 256; u.ocol = (pm >> 4) * 1024 + pn * 256; u.aux = 0; return true;
    }
};
template <int NPN>
struct SchedRows {
    const char* A; const char* Bt; int K, nunits, G, v;
    DEVI int rot() const { return 0; }
    DEVI bool next(int i, Unit& u) const {
        const int L = i * G + v; if (L >= nunits) return false;
        const int grp = L / (8 * NPN), j = L % (8 * NPN), pm = grp * 8 + (j & 7), pn = j >> 3;
        u.a = A + (size_t)pm * 256 * K * 2; u.b = Bt + (size_t)pn * 256 * K * 2;
        u.orow = pm * 256; u.ocol = pn * 256; u.aux = pn; return true;
    }
};
struct SchedVT {
    const char* Wv; const char* HN; int G, v, v0;
    DEVI int rot() const { return 0; }
    DEVI bool next(int i, Unit& u) const {
        const int L = i * G + v - v0; if (L < 0 || L >= T / 256) return false;
        u.a = Wv; u.b = HN + (size_t)L * 256 * D; u.orow = 0; u.ocol = L * 256; u.aux = 1280; return true;
    }
};
template <int NPN> DEVI bool moe_unit(int i, int G, int v, int ntiles, int& tr, int& pn) {
    if ((G & 7) == 0) {
        const int P = G >> 3, x = v / P, j = v - x * P, r0 = (x * ntiles) >> 3, r1 = ((x + 1) * ntiles) >> 3, q = i * P + j;
        tr = r0 + q / NPN; pn = q % NPN; return tr < r1;
    }
    const int L = i * G + v; tr = L / NPN; pn = L % NPN; return L < ntiles * NPN;
}
template <int NPN> DEVI int moe_rot(int G, int v) {
    if ((G & 7) != 0) return 0;
    const int P = G >> 3, j = v % P, pn = j % NPN, tl = j / NPN;
    return NPN == 8 ? (pn + 2 * tl) & 7 : (2 * pn + tl) & 7;
}
template <int NPN> DEVI void moe_stagger(int G, int v, int ntiles) {
    if ((G & 7) != 0) return;
    const int P = G >> 3, x = v / P, j = v - x * P, r0 = (x * ntiles) >> 3, r1 = ((x + 1) * ntiles) >> 3, U = (r1 - r0) * NPN;
    const int rounds = (U + P - 1) / P; const bool has_last = (rounds - 1) * P + j < U;
    const int steps = has_last ? (j & 1) : 2 + ((j * 5) & 7);
    for (int k = 0; k < steps; ++k) __builtin_amdgcn_s_sleep(22);
}
template <int NPN, int WROWS, int OCW, bool AUXB, int RB  >
struct SchedMoE {
    const char* A; const char* W; const LAS int* tile_e; int ntiles, G, v;
    DEVI int rot() const { return moe_rot<NPN>(G, v); }
    DEVI bool next(int i, Unit& u) const {
        int tr, pn; if (!moe_unit<NPN>(i, G, v, ntiles, tr, pn)) return false;
        const int e = __builtin_amdgcn_readfirstlane(tile_e[tr]);
        u.a = A + (size_t)tr * 256 * RB; u.b = W + ((size_t)e * WROWS + pn * 256) * RB;
        u.orow = tr * 256; u.ocol = pn * OCW; u.aux = AUXB ? e * D + pn * OCW : e; return true;
    }
};

template <int NPN, int WROWS, int OCW, int RB>
struct SchedMoEG {
    const char* A; const char* W; const LAS int* tile_e; const int* slot_tok; const LAS int* pst; int ntiles, G, v;
    DEVI int goff(const Unit& u) const { return u.aux * ETOK_E + u.orow - __builtin_amdgcn_readfirstlane(pst[u.aux]); }
    DEVI int rot() const { return moe_rot<NPN>(G, v); }
    DEVI bool next(int i, Unit& u) const {
        int tr, pn; if (!moe_unit<NPN>(i, G, v, ntiles, tr, pn)) return false;
        const int e = __builtin_amdgcn_readfirstlane(tile_e[tr]);
        u.a = A; u.b = W + ((size_t)e * WROWS + pn * 256) * RB;
        u.orow = tr * 256; u.ocol = pn * OCW; u.aux = e; return true;
    }
};

#define XB_TMO      128
#define XB_XCNT(j)  (256  + 64 * (j))
#define XB_XSUB(j)  (1280 + 64 * (j))
#define XB_XGEN(j)  (2304 + 64 * (j))
#define XB_TOP      3328
#define XB_TOPGEN   3392
#define XCD_BAR_WORDS 3456
#define XB_SPIN_CAP (1u << 20)
DEVI unsigned xb_ld(unsigned* p)              { return __hip_atomic_load(p, RLX_AGENT); }
DEVI unsigned xb_add(unsigned* p, unsigned v) { return __hip_atomic_fetch_add(p, v, RLX_AGENT); }
DEVI unsigned xb_xcc_id() { return (unsigned)__builtin_amdgcn_s_getreg((3 << 11) | 20) & 0xFu; }
#define XB_SPIN(cond, bar) do { unsigned _sp = 0; while (cond) { __builtin_amdgcn_s_sleep(1); \
    if ((++_sp & 255u) == 0u) { if (xb_ld(&(bar)[XB_TMO])) break; if (_sp > XB_SPIN_CAP) { atomicAdd(&(bar)[XB_TMO], 1u); break; } } } } while (0)
struct XcdBarrier { unsigned* bar; unsigned x; volatile LAS unsigned* st; };
DEVI XcdBarrier xcd_barrier_post(unsigned* bar, volatile LAS unsigned* st) {
    XcdBarrier b; b.bar = bar; b.x = xb_xcc_id(); b.st = st;
    if (threadIdx.x == 0) (void)xb_add(&bar[XB_XCNT(b.x)], 1u);
    return b;
}
DEVI void xcd_barrier_complete(unsigned* bar, unsigned x, unsigned& nloc, unsigned& nx) {
    const unsigned G = gridDim.x * gridDim.y * gridDim.z;
    unsigned sum, cnt, mine, sp = 0u;
    for (;;) {
        sum = 0u; cnt = 0u; mine = 0u;
#pragma unroll
        for (unsigned j = 0; j < 16; ++j) { const unsigned c = xb_ld(&bar[XB_XCNT(j)]); sum += c; cnt += (c > 0u) ? 1u : 0u; mine = (j == x) ? c : mine; }
        if (sum == G) break;
        __builtin_amdgcn_s_sleep(1);
        if ((++sp & 255u) == 0u) { if (xb_ld(&bar[XB_TMO])) break; if (sp > XB_SPIN_CAP) { atomicAdd(&bar[XB_TMO], 1u); break; } }
    }
    nloc = mine > 0u ? mine : 1u; nx = cnt > 0u ? cnt : 1u;
}
struct NoWork { DEVI void operator()() const {} };
template <class W = NoWork>
DEVI void xcd_barrier(const XcdBarrier& b, const W& work = W()) {
    asm volatile("s_waitcnt vmcnt(0)" ::: "memory");
    __syncthreads();
    if (threadIdx.x >= 64) work();
    if (threadIdx.x == 0) {
        unsigned* bar = b.bar; asm volatile("" : "+s"(bar));
        __builtin_amdgcn_s_waitcnt(0);
        unsigned nloc = b.st[0], nx = b.st[1];
        if (nloc == 0u) { xcd_barrier_complete(bar, b.x, nloc, nx); b.st[0] = nloc; b.st[1] = nx; }
        const unsigned old = xb_add(&bar[XB_XSUB(b.x)], 1u);
        const unsigned gen = old / nloc;
        if (old + 1u == (gen + 1u) * nloc) {
            __builtin_amdgcn_fence(__ATOMIC_RELEASE, "agent");
            asm volatile("s_waitcnt vmcnt(0)" ::: "memory");
            const unsigned og = xb_add(&bar[XB_TOP], 1u);
            const unsigned tg = og / nx;
            if (og + 1u == (tg + 1u) * nx) xb_add(&bar[XB_TOPGEN], 1u);
            else XB_SPIN(xb_ld(&bar[XB_TOPGEN]) == tg, bar);
            __builtin_amdgcn_fence(__ATOMIC_ACQUIRE, "agent");
            xb_add(&bar[XB_XGEN(b.x)], 1u);
            asm volatile("s_waitcnt vmcnt(0)" ::: "memory");
        } else {
            XB_SPIN(xb_ld(&bar[XB_XGEN(b.x)]) == gen, bar);
            __builtin_amdgcn_fence(__ATOMIC_ACQUIRE, "agent");
            asm volatile("s_waitcnt vmcnt(0)" ::: "memory");
        }
    }
    __syncthreads();
}

struct Ctx { LAS unsigned char* lds; int tid, lane, wave, v, G; };
DEVI Ctx refresh(const Ctx& c0) { Ctx c = c0; c.tid = opaque_tid(); c.lane = c.tid & 63; return c; }

DEVI void transpose_item64_f8(const float* W, int ldw, int k0, int ca, int cb, unsigned char* dst, int K, int rho0, LAS float* scr, int lane) {
    const int r = lane >> 4, q = lane & 15, cs = (q < 8) ? ca + 4 * q : cb + 4 * (q - 8);
    const float* src = W + (size_t)(k0 + r) * ldw + cs;
    f32x4 v[16];
#pragma unroll
    for (int i = 0; i < 16; ++i) v[i] = *(const f32x4*)(src + (size_t)(4 * i) * ldw);
#pragma unroll
    for (int i = 0; i < 16; ++i) { LAS float* t = scr + (4 * i + r) * 65 + 4 * q; t[0] = v[i].x * WSCALE; t[1] = v[i].y * WSCALE; t[2] = v[i].z * WSCALE; t[3] = v[i].w * WSCALE; }
    asm volatile("s_waitcnt lgkmcnt(0)" ::: "memory");
    const int kc = lane & 3, nn = lane >> 2;
#pragma unroll
    for (int j = 0; j < 4; ++j) { const int n = nn + 16 * j; const LAS float* t = scr + (16 * kc) * 65 + n;
        u32x4 o; o.x = pk4f8(t[0 * 65], t[1 * 65], t[2 * 65], t[3 * 65]); o.y = pk4f8(t[4 * 65], t[5 * 65], t[6 * 65], t[7 * 65]);
        o.z = pk4f8(t[8 * 65], t[9 * 65], t[10 * 65], t[11 * 65]); o.w = pk4f8(t[12 * 65], t[13 * 65], t[14 * 65], t[15 * 65]);
        *(u32x4*)(dst + (size_t)(rho0 + n) * K + k0 + 16 * kc) = o; }
    asm volatile("s_waitcnt lgkmcnt(0)" ::: "memory");
}
DEVI void transpose_item64(const float* W, int ldw, int k0, int ca, int cb, bf16_t* dst, int K, int rho0, LAS float* scr, int lane) {
    const int r = lane >> 4, q = lane & 15, cs = (q < 8) ? ca + 4 * q : cb + 4 * (q - 8);
    const float* src = W + (size_t)(k0 + r) * ldw + cs;
    f32x4 v[16];
#pragma unroll
    for (int i = 0; i < 16; ++i) v[i] = *(const f32x4*)(src + (size_t)(4 * i) * ldw);
#pragma unroll
    for (int i = 0; i < 16; ++i) { LAS float* t = scr + (4 * i + r) * 65 + 4 * q; t[0] = v[i].x; t[1] = v[i].y; t[2] = v[i].z; t[3] = v[i].w; }
    asm volatile("s_waitcnt lgkmcnt(0)" ::: "memory");
    const int kc = lane & 7, nn = lane >> 3;
#pragma unroll
    for (int j = 0; j < 8; ++j) { const int n = nn + 8 * j; const LAS float* t = scr + (8 * kc) * 65 + n;
        u32x4 o; o.x = pk2(t[0 * 65], t[1 * 65]); o.y = pk2(t[2 * 65], t[3 * 65]); o.z = pk2(t[4 * 65], t[5 * 65]); o.w = pk2(t[6 * 65], t[7 * 65]);
        *(u32x4*)(dst + (size_t)(rho0 + n) * K + k0 + 8 * kc) = o; }
    asm volatile("s_waitcnt lgkmcnt(0)" ::: "memory");
}

struct TrItem { const float* src; size_t ldw4; unsigned char* dst; int k0, rho0; bool f8; const float* gsc; bool kperm; };
DEVI void tr_load(const TrItem& t, f32x4 (&v)[16]) {
#pragma unroll
    for (int i = 0; i < 16; ++i) v[i] = __builtin_nontemporal_load((const f32x4*)(t.src + (size_t)i * t.ldw4));
}
DEVI void tr_finish(const TrItem& t, const f32x4 (&v)[16], LAS float* scr, int lane) {
    if (t.f8) {
        const int r = lane >> 3, q = lane & 7;
#pragma unroll
        for (int i = 0; i < 16; ++i) { const int rr = 8 * i + r, prow = t.kperm ? ((rr & 64) | (((rr >> 2) & 1) << 5) | (((rr >> 5) & 1) << 4) | (((rr >> 3) & 3) << 2) | (rr & 3)) : rr;
            LAS float* p = scr + prow * 33 + 4 * q; p[0] = v[i].x * WSCALE; p[1] = v[i].y * WSCALE; p[2] = v[i].z * WSCALE; p[3] = v[i].w * WSCALE; }
        asm volatile("s_waitcnt lgkmcnt(0)" ::: "memory");
        const int kc = lane & 7, nn = lane >> 3;
#pragma unroll
        for (int j = 0; j < 4; ++j) { const int n = nn + 8 * j; const LAS float* p = scr + (16 * kc) * 33 + n;
            u32x4 o; o.x = pk4f8(p[0 * 33], p[1 * 33], p[2 * 33], p[3 * 33]); o.y = pk4f8(p[4 * 33], p[5 * 33], p[6 * 33], p[7 * 33]);
            o.z = pk4f8(p[8 * 33], p[9 * 33], p[10 * 33], p[11 * 33]); o.w = pk4f8(p[12 * 33], p[13 * 33], p[14 * 33], p[15 * 33]);
            *(u32x4*)(t.dst + (size_t)(t.rho0 + n) * D + t.k0 + 16 * kc) = o; }
    } else {
        const int r = lane >> 4, q = lane & 15;
#pragma unroll
        for (int i = 0; i < 16; ++i) { LAS float* p = scr + (4 * i + r) * 65 + 4 * q; const float gk = t.gsc ? t.gsc[t.k0 + 4 * i + r] : 1.0f; p[0] = v[i].x * gk; p[1] = v[i].y * gk; p[2] = v[i].z * gk; p[3] = v[i].w * gk; }
        asm volatile("s_waitcnt lgkmcnt(0)" ::: "memory");
        const int kc = lane & 7, nn = lane >> 3;
#pragma unroll
        for (int j = 0; j < 8; ++j) { const int n = nn + 8 * j; const LAS float* p = scr + (8 * kc) * 65 + n;
            u32x4 o; o.x = pk2(p[0 * 65], p[1 * 65]); o.y = pk2(p[2 * 65], p[3 * 65]); o.z = pk2(p[4 * 65], p[5 * 65]); o.w = pk2(p[6 * 65], p[7 * 65]);
            *(u32x4*)((bf16_t*)t.dst + (size_t)(t.rho0 + n) * D + t.k0 + 8 * kc) = o; }
    }
    asm volatile("s_waitcnt lgkmcnt(0)" ::: "memory");
}
struct In { const float* p[17]; };
DEVI const float* inptr(const Ctx& c, int i) {
    const LAS unsigned* q = (const LAS unsigned*)(c.lds + LDSCTL_OFF + LC_PTRS + 8 * i);
    const unsigned lo = __builtin_amdgcn_readfirstlane(q[0]), hi = __builtin_amdgcn_readfirstlane(q[1]);
    return (const float*)(((unsigned long long)hi << 32) | lo);
}

constexpr int TR_I_GU = 16 * 32, TR_I_D = 16 * 16, TR_N_GU = 64 * TR_I_GU, TR_N_D = 64 * TR_I_D, TR_I_QKV = 16 * 24, TR_I_O = 16 * 16, TR_NIT = TR_N_GU + TR_N_D + TR_I_QKV + TR_I_O;
constexpr int TR_NSEAM = 10, TR_SEAM_SMALL = TR_I_QKV + TR_I_O, TR_SEAM_GU0 = 17280, TR_SEAM_NGU = TR_N_GU - TR_SEAM_GU0, TR_SEAM_ND = 896, TR_SEAM_D0 = TR_N_GU + TR_N_D - TR_SEAM_ND, TR_SEAM_LIST = TR_SEAM_SMALL + TR_SEAM_NGU + TR_SEAM_ND;
static_assert(TR_SEAM_SMALL + TR_SEAM_NGU == 9 * 1792 && TR_SEAM_LIST <= 10 * 1792 && TR_NIT - TR_SEAM_LIST == 16 * 2048, "barrier-shadow conversion plan");
DEVI int seam_list_item(int q) { return q < TR_SEAM_SMALL ? TR_N_GU + TR_N_D + q : q < TR_SEAM_SMALL + TR_SEAM_NGU ? TR_SEAM_GU0 + (q - TR_SEAM_SMALL) : TR_SEAM_D0 + (q - TR_SEAM_SMALL - TR_SEAM_NGU); }
DEVI void decode_item(const Ctx& c, unsigned char* ws, int it, TrItem& t) {
    constexpr int I_GU = TR_I_GU, I_D = TR_I_D, N_GU = TR_N_GU, N_D = TR_N_D, I_QKV = TR_I_QKV;
    const int lr = c.lane >> 4, lq = c.lane & 15;

            int r = it; const float* W; int ldw, ca, cb;
            bool wide = false; t.gsc = nullptr; t.kperm = false;
            if (r < N_GU) {
                const int le = r / I_GU, q = r % I_GU; t.f8 = (le >> 5) ? F8L1 : F8L0; wide = t.f8;
                const int kb = wide ? (q >> 6) : (q >> 5), rb = wide ? (q & 63) : (q & 31), rho0 = wide ? rb * 32 : rb * 64;
                const int pn = rho0 >> 8, bj = (rho0 >> 7) & 1, i = rho0 & 127, c0 = bj * 1024 + pn * 128 + i;
                t.dst = ws + WS_WGU + (size_t)(le >> 5) * 128 * MiB + (size_t)(le & 31) * 2048 * D * (t.f8 ? 1 : 2);
                W = inptr(c, 12) + (size_t)le * D * 2048; ldw = 2048; ca = c0; cb = c0 + 32; t.k0 = kb * (wide ? 128 : 64); t.rho0 = rho0;
            } else if ((r -= N_GU) < N_D) {
                const int le = r / I_D, q = r % I_D; t.f8 = (le >> 5) ? F8L1 : F8L0; wide = t.f8;
                const int kb = wide ? (q >> 5) : (q >> 4), rb = wide ? (q & 31) : (q & 15), rho0 = wide ? rb * 32 : rb * 64;
                t.dst = ws + WS_WD + (size_t)(le >> 5) * 64 * MiB + (size_t)(le & 31) * D * D * (t.f8 ? 1 : 2);
                W = inptr(c, 14) + (size_t)le * D * D; ldw = D; ca = rho0; cb = ca + 32; t.k0 = kb * (wide ? 128 : 64); t.rho0 = rho0;
            } else if ((r -= N_D) < I_QKV) {
                const int kb = r / 48, rb = r % 48, rho0 = rb * 32, p0 = rho0 & ~63; ca = rho0; cb = ca + 32;
                if (p0 < 1280) { const int pn = p0 >> 8, bj = (p0 >> 7) & 1, q = p0 & 127; ca = pn * 256 + (q >> 5) * 64 + 32 * bj + ((rho0 & 32) ? 64 : 0); }
                t.f8 = true; wide = true; t.dst = ws + WS_WQKV; W = inptr(c, 5); ldw = QKVD; t.k0 = kb * 128; t.rho0 = rho0;
            } else {
                r -= I_QKV; const int kb = r >> 5, rb = r & 31;
                t.f8 = true; wide = true; t.kperm = true; t.dst = ws + WS_WO; W = inptr(c, 8); ldw = D; ca = rb * 32; cb = ca + 32; t.k0 = kb * 128; t.rho0 = rb * 32;
            }
            if (wide) { t.src = W + (size_t)(t.k0 + (c.lane >> 3)) * ldw + ca + 4 * (c.lane & 7); t.ldw4 = (size_t)8 * ldw; }
            else { t.src = W + (size_t)(t.k0 + lr) * ldw + ((lq < 8) ? ca + 4 * lq : cb + 4 * (lq - 8)); t.ldw4 = (size_t)4 * ldw; }
        }
struct ConvWork {
    LAS unsigned char* lds; unsigned char* ws; int v, G, seam;
    DEVI void operator()() const {
        Ctx c; c.lds = lds; c.tid = opaque_tid(); c.lane = c.tid & 63; c.wave = __builtin_amdgcn_readfirstlane(c.tid >> 6); c.v = v; c.G = G;
        const int q = seam * 7 * G + v * 7 + (c.wave - 1);
        if (G == 256 && q < TR_SEAM_LIST) { TrItem t; f32x4 va[16]; decode_item(c, ws, seam_list_item(q), t); tr_load(t, va); tr_finish(t, va, (LAS float*)(lds + c.wave * 16896), c.lane); }
    }
};
constexpr int TC_N = 7296, TC_ITEM0 = TR_N_GU + TR_N_D / 2;
static_assert(TC_ITEM0 + TC_N == TR_SEAM_D0, "tail-conversion items = layer 1 down items not in the barrier list");
template <int NPN> DEVI void moe_tail(const Ctx& c0, unsigned char* ws, int ntiles, int qbase, int qend, int NW, int K) {
    const Ctx c = refresh(c0);
    const int G = c.G, v = c.v;
    if ((G & 7) != 0) return;
    const int P = G >> 3, x = v / P, j = v - x * P;
    int ni_before = 0, nb_before = 0, NI = 0, myrem = 0;
    for (int xx = 0; xx < 8; ++xx) {
        const int r0 = (xx * ntiles) >> 3, r1 = ((xx + 1) * ntiles) >> 3, U = (r1 - r0) * NPN, rem = U % P, idle = rem ? P - rem : 0;
        if (xx < x) { ni_before += idle; nb_before += P - idle; }
        if (xx == x) myrem = rem;
        NI += idle;
    }
    const bool has_last = (myrem == 0) || (j < myrem);
    const int slot = has_last ? NI + nb_before + j : ni_before + (j - myrem);
    const bool conv = (MK_N_LAUNCHES == 1 && G == 256 && slot < NW);
    if (conv) {
        LAS float* scr = (LAS float*)(c.lds + c.wave * 16896);
        TrItem cur, nxt; f32x4 va[16], vb[16];
        const int q0 = qbase + slot * 8 + c.wave, qs = NW * 8;
        if (q0 < qend) { decode_item(c, ws, TC_ITEM0 + q0, cur); tr_load(cur, va); }
        for (int i = 0; i < K; ++i) {
            const int q = q0 + i * qs; if (q >= qend) break;
            const bool hn = (i + 1 < K) && (q + qs < qend);
            if (hn) { decode_item(c, ws, TC_ITEM0 + q + qs, nxt); tr_load(nxt, vb); }
            tr_finish(cur, va, scr, c.lane);
            if (hn) { cur = nxt;
#pragma unroll
                for (int u = 0; u < 16; ++u) va[u] = vb[u]; }
        }
    }
}
DEVI void p0_prologue(const Ctx& c0, unsigned char* ws) {
    const Ctx c = refresh(c0);
    const int gw = c.v * 8 + c.wave, NGW = c.G * 8;
    {
        LAS float* scr = (LAS float*)(c.lds + c.wave * 16896);
        const int seam_total = (MK_N_LAUNCHES == 1 && c.G == 256) ? TR_SEAM_LIST : 0;
        const int n_main = TR_NIT - TR_SEAM_LIST - ((MK_N_LAUNCHES == 1 && c.G == 256) ? TC_N : 0), NIT = n_main + (TR_SEAM_LIST - seam_total);
        auto item_of = [&](int p) { return p < TR_SEAM_GU0 ? p : p < n_main ? p + TR_SEAM_NGU : seam_list_item(seam_total + (p - n_main)); };
        auto decode = [&](int p, TrItem& t) { decode_item(c, ws, item_of(p), t); };
        TrItem cur, nxt; f32x4 va[16], vb[16];
        if (gw < NIT) { decode(gw, cur); tr_load(cur, va); }
        for (int it = gw; it < NIT; it += NGW) {
            const bool hn = it + NGW < NIT;
            if (hn) { decode(it + NGW, nxt); tr_load(nxt, vb); }
            tr_finish(cur, va, scr, c.lane);
            if (hn) { cur = nxt;
#pragma unroll
                for (int i = 0; i < 16; ++i) va[i] = vb[i]; }
        }
    }
    __syncthreads();
    LAS float* tab = (LAS float*)c.lds; LAS float* tab128 = tab + 4096;
    for (int k = c.tid; k < 4096; k += 512) tab[k] = cospif((float)k * (1.0f / 2048.0f));
    if (c.tid < 128) tab128[c.tid] = cospif((float)c.tid * (1.0f / 64.0f));
    __syncthreads();
    {
        u32x4* et = (u32x4*)(ws + WS_XS);
        for (int i = c.v * 512 + c.tid; i < 2 * NE * ETOK_E / 4; i += c.G * 512) et[i] = (u32x4){0u, 0u, 0u, 0u};
    }
    {
        float* TW = (float*)(ws + WS_TW);
        const int gt = c.v * 512 + c.tid;
        if (gt < 4096) { const int k1 = gt >> 6, bb = gt & 63; const float a = (float)(k1 * bb) * (1.0f / 2048.0f); TW[2 * gt] = cospif(a); TW[2 * gt + 1] = sinpif(a); }
    }
    {
        const float* wo = inptr(c, 3); bf16_t* WP = (bf16_t*)(ws + WS_WP);
        const float scale = 1.0f / sqrtf((float)SEQ * 128.0f);
        const int l15 = c.lane & 15, kq = c.lane >> 4;
        for (int task = c.wave * c.G + c.v; task < 1024; task += 8 * c.G) {
            const int half = task >> 9, g = (task >> 6) & 7, nb = task & 63;
            const float* wsrc = wo + (size_t)(g * 128 + kq) * D + nb * 16 + l15;
            float bvv[32];
#pragma unroll
            for (int ks = 0; ks < 32; ++ks) bvv[ks] = wsrc[(size_t)(4 * ks) * D];
            f32x4 a[8];
#pragma unroll
            for (int ccb = 0; ccb < 8; ++ccb) a[ccb] = (f32x4){0.f, 0.f, 0.f, 0.f};
#pragma unroll
            for (int ks = 0; ks < 32; ++ks) {
                const int cp = 4 * ks + kq;
#pragma unroll
                for (int ccb = 0; ccb < 8; ++ccb) {
                    const float tv = tab128[((ccb * 16 + l15) * cp - (half ? 32 : 0)) & 127];
                    a[ccb] = __builtin_amdgcn_mfma_f32_16x16x4f32(tv, bvv[ks], a[ccb], 0, 0, 0);
                }
            }
            const float sg = half ? -scale : scale;
            bf16_t* dst = WP + (size_t)half * D * D + (size_t)(nb * 16 + l15) * D + g * 128 + 4 * kq;
#pragma unroll
            for (int ccb = 0; ccb < 8; ++ccb) { u32x2 o; o.x = pk2(a[ccb][0] * sg, a[ccb][1] * sg); o.y = pk2(a[ccb][2] * sg, a[ccb][3] * sg); *(u32x2*)(dst + ccb * 16) = o; }
        }
    }
    {
        float* cosT = (float*)(ws + WS_COS); float* sinT = (float*)(ws + WS_SIN);
        const int gt = c.v * 512 + c.tid, NT_ = c.G * 512;
        for (int i = gt; i < SEQ * 32; i += NT_) {
            const int s = i >> 5, j = i & 31;
            const float inv_freq = powf(10000.0f, -(float)(2 * j) / 64.0f);
            const float ang = (float)s * inv_freq;
            cosT[i] = cosf(ang); sinT[i] = sinf(ang);
        }
    }
    __syncthreads();
    {
        const float* x = inptr(c, 0); const float* g = inptr(c, 1); bf16_t* HT = (bf16_t*)(ws + WS_HT);
        LAS bf16_t* tile = (LAS bf16_t*)c.lds; constexpr int TS = 1026;
        f32x4 gg[4];
#pragma unroll
        for (int j = 0; j < 4; ++j) gg[j] = *((const f32x4*)g + c.lane + 64 * j);
        for (int blk = c.v; blk < T / 64; blk += c.G) {
            const int bat = blk >> 6, b0 = blk & 63;
            f32x4 va[4][4], vb[4][4];
#pragma unroll
            for (int i = 0; i < 4; ++i) { const f32x4* xr = (const f32x4*)(x + ((size_t)bat * SEQ + 64 * (c.wave * 8 + i) + b0) * D) + c.lane;
#pragma unroll
                for (int j = 0; j < 4; ++j) va[i][j] = __builtin_nontemporal_load(xr + 64 * j); }
#pragma unroll
            for (int i = 0; i < 4; ++i) { const f32x4* xr = (const f32x4*)(x + ((size_t)bat * SEQ + 64 * (c.wave * 8 + 4 + i) + b0) * D) + c.lane;
#pragma unroll
                for (int j = 0; j < 4; ++j) vb[i][j] = __builtin_nontemporal_load(xr + 64 * j); }
#pragma unroll
            for (int i = 0; i < 8; ++i) {
                const int tl = c.wave * 8 + i;
                f32x4 v[4]; float s = 0.f;
#pragma unroll
                for (int j = 0; j < 4; ++j) { v[j] = (i < 4) ? va[i & 3][j] : vb[i & 3][j]; s += v[j].x * v[j].x + v[j].y * v[j].y + v[j].z * v[j].z + v[j].w * v[j].w; }
                const float r = rsqrtf(wave_sum(s) * (1.0f / D) + RMS_EPS);
#pragma unroll
                for (int j = 0; j < 4; ++j) {
                    u32x2 w; w.x = pk2(v[j].x * r * gg[j].x, v[j].y * r * gg[j].y); w.y = pk2(v[j].z * r * gg[j].z, v[j].w * r * gg[j].w);
                    LAS unsigned* tp = (LAS unsigned*)(tile + tl * TS + 256 * j + 4 * c.lane); tp[0] = w.x; tp[1] = w.y;
                }
            }
            __syncthreads();
            for (int it = c.tid; it < 1024 * 8; it += 512) {
                const int o8 = it & 7, ch = it >> 3;
                unsigned short e[8];
#pragma unroll
                for (int j = 0; j < 8; ++j) e[j] = tile[(o8 * 8 + j) * TS + ch];
                u32x4 o; o.x = e[0] | ((unsigned)e[1] << 16); o.y = e[2] | ((unsigned)e[3] << 16); o.z = e[4] | ((unsigned)e[5] << 16); o.w = e[6] | ((unsigned)e[7] << 16);
                *(u32x4*)(HT + (((size_t)bat * D + ch) * 64 + b0) * 64 + o8 * 8) = o;
            }
            __syncthreads();
        }
    }
}

struct F64Frags { bf16x8 C[2][4], S[2][4]; };
DEVI void make_f64(const Ctx& c, F64Frags& f) {
    LAS float* tab = (LAS float*)c.lds;
    __syncthreads();
    if (c.tid < 64) tab[c.tid] = cospif((float)c.tid * (1.0f / 32.0f));
    __syncthreads();
    const int r32 = c.lane & 31, hi = c.lane >> 5;
#pragma unroll
    for (int t = 0; t < 2; ++t)
#pragma unroll
        for (int ks = 0; ks < 4; ++ks) {
            union { bf16x8 v; unsigned w[4]; } cv, sv;
#pragma unroll
            for (int j = 0; j < 4; ++j) {
                const int q = r32 + 32 * t, k0 = 16 * ks + 8 * hi + 2 * j, i0 = (q * k0) & 63, i1 = (q * (k0 + 1)) & 63;
                cv.w[j] = pk2(tab[i0], tab[i1]); sv.w[j] = pk2(tab[(i0 - 16) & 63], tab[(i1 - 16) & 63]);
            }
            f.C[t][ks] = cv.v; f.S[t][ks] = sv.v;
        }
}
constexpr int FFT_STG = 2 * 64 * 33 * 4;
static_assert(8 * FFT_STG <= LDSCTL_OFF, "fft stage fits under the LDS control area");
DEVI void fft1_phase(const Ctx& c0, const F64Frags& f, const bf16_t* HT2, const float* TW, bf16_t* Y2) {
    const Ctx c = refresh(c0);
    LAS unsigned* stg = (LAS unsigned*)(c.lds + c.wave * FFT_STG);
    const int r32 = c.lane & 31, hi = c.lane >> 5;
    const int gw = c.v * 8 + c.wave, NGW = c.G * 8;
    bf16x8 xn[4];
    if (gw < BATCH * D) {
#pragma unroll
        for (int ks = 0; ks < 4; ++ks) xn[ks] = __builtin_nontemporal_load((const bf16x8*)(HT2 + (size_t)gw * 4096 + r32 * 64 + 16 * ks + 8 * hi));
    }
    for (int item = gw; item < BATCH * D; item += NGW) {
        const int bat = item >> 10, ch = item & 1023;
#pragma unroll 1
        for (int bt = 0; bt < 2; ++bt) {
            bf16x8 xf[4];
#pragma unroll
            for (int ks = 0; ks < 4; ++ks) xf[ks] = xn[ks];
            {
                const int nitem = bt ? item + NGW : item, nbt = bt ^ 1;
                if (nitem < BATCH * D) {
#pragma unroll
                    for (int ks = 0; ks < 4; ++ks) xn[ks] = __builtin_nontemporal_load((const bf16x8*)(HT2 + (size_t)nitem * 4096 + (32 * nbt + r32) * 64 + 16 * ks + 8 * hi));
                }
            }
            f32x16 P, Q;
            const f32x16 z16 = {0.f, 0.f, 0.f, 0.f, 0.f, 0.f, 0.f, 0.f, 0.f, 0.f, 0.f, 0.f, 0.f, 0.f, 0.f, 0.f};
            float p32 = 0.f;
#pragma unroll
            for (int ks = 0; ks < 4; ++ks) {
                P = __builtin_amdgcn_mfma_f32_32x32x16_bf16(xf[ks], f.C[0][ks], ks == 0 ? z16 : P, 0, 0, 0);
                Q = __builtin_amdgcn_mfma_f32_32x32x16_bf16(xf[ks], f.S[0][ks], ks == 0 ? z16 : Q, 0, 0, 0);
#pragma unroll
                for (int j = 0; j < 8; ++j) { const float xv = __builtin_bit_cast(float, (unsigned)(unsigned short)xf[ks][j] << 16); p32 += (j & 1) ? -xv : xv; }
            }
            p32 = sum32(p32);
            {
                const int k1 = r32;
#pragma unroll
                for (int i = 0; i < 4; ++i) {
                    const int b0 = 32 * bt + 8 * i + 4 * hi;
                    const f32x4 t0 = *(const f32x4*)(TW + (k1 * 64 + b0) * 2), t1 = *(const f32x4*)(TW + (k1 * 64 + b0) * 2 + 4);
                    const float cs[4] = {t0.x, t0.z, t1.x, t1.z}, sn[4] = {t0.y, t0.w, t1.y, t1.w};
                    float tr[4], ti[4];
#pragma unroll
                    for (int j = 0; j < 4; ++j) { const float pp = P[4 * i + j], qq = Q[4 * i + j]; tr[j] = pp * cs[j] - qq * sn[j]; ti[j] = pp * sn[j] + qq * cs[j]; }
                    LAS unsigned* sp = stg + k1 * 33 + (b0 >> 1);
                    sp[0] = pk2(tr[0], tr[1]); sp[1] = pk2(tr[2], tr[3]);
                    sp[64 * 33] = pk2(ti[0], ti[1]); sp[64 * 33 + 1] = pk2(ti[2], ti[3]);
                }
            }
            {
                const int b = 32 * bt + r32;
                const f32x2 tw = *(const f32x2*)(TW + (32 * 64 + b) * 2);
                ((LAS unsigned short*)(stg + (hi ? 64 * 33 : 0) + 32 * 33))[b] = (unsigned short)f2bf(p32 * (hi ? tw.y : tw.x));
            }
        }
        asm volatile("s_waitcnt lgkmcnt(0)" ::: "memory");
#pragma unroll
        for (int it = 0; it < 8; ++it) {
            const int part = it >> 2, row = (it & 3) * 8 + (c.lane >> 3), chunk = c.lane & 7;
            const LAS unsigned* sp = stg + (part * 64 + row) * 33 + chunk * 4;
            u32x4 w; w.x = sp[0]; w.y = sp[1]; w.z = sp[2]; w.w = sp[3];
            *(u32x4*)(Y2 + ((((size_t)bat * 64 + row) * 2 + part) * 1024 + ch) * 64 + chunk * 8) = w;
        }
        if (c.lane < 16) {
            const int part = c.lane >> 3, chunk = c.lane & 7;
            const LAS unsigned* sp = stg + (part * 64 + 32) * 33 + chunk * 4;
            u32x4 w; w.x = sp[0]; w.y = sp[1]; w.z = sp[2]; w.w = sp[3];
            *(u32x4*)(Y2 + ((((size_t)bat * 64 + 32) * 2 + part) * 1024 + ch) * 64 + chunk * 8) = w;
        }
        asm volatile("s_waitcnt lgkmcnt(0)" ::: "memory");
    }
}
DEVI void fft2_phase(const Ctx& c0, const F64Frags& f, const bf16_t* Y2, bf16_t* UB, bf16_t* VB, bf16_t* U2048) {
    const Ctx c = refresh(c0);
    LAS unsigned* stg = (LAS unsigned*)(c.lds + c.wave * FFT_STG);
    const int r32 = c.lane & 31, hi = c.lane >> 5;
    const int gw = c.v * 8 + c.wave, NGW = c.G * 8;
    bf16x8 trn[4], tin[4];
#define F2_BAT(it_) ((it_) < 4096 ? (it_) >> 9 : ((it_) - 4096) >> 4)
#define F2_K1(it_) ((it_) < 4096 ? ((it_) >> 4) & 31 : 32)
#define F2_ADDR(it_, sub_) (Y2 + ((((size_t)F2_BAT(it_) * 64 + F2_K1(it_)) * 2) * 1024 + 64 * ((it_) & 15) + 32 * (sub_) + r32) * 64 + 8 * hi)
    constexpr int NIT2 = BATCH * 33 * 16;
    if (gw < NIT2) {
        const bf16_t* yb = F2_ADDR(gw, 0);
#pragma unroll
        for (int ks = 0; ks < 4; ++ks) { trn[ks] = __builtin_nontemporal_load((const bf16x8*)(yb + 16 * ks)); tin[ks] = __builtin_nontemporal_load((const bf16x8*)(yb + 1024 * 64 + 16 * ks)); }
    }
    for (int item = gw; item < NIT2; item += NGW) {
        const int ct = item & 15, k1 = F2_K1(item), bat = F2_BAT(item), c0 = 64 * ct;
#pragma unroll 1
        for (int sub = 0; sub < 2; ++sub) {
            bf16x8 trf[4], tif[4], ntf[4];
#pragma unroll
            for (int ks = 0; ks < 4; ++ks) { trf[ks] = trn[ks]; tif[ks] = tin[ks]; ntf[ks] = tif[ks] ^ (short)0x8000; }
            {
                const int nitem = sub ? item + NGW : item, nsub = sub ^ 1;
                if (nitem < NIT2) {
                    const bf16_t* yb = F2_ADDR(nitem, nsub);
#pragma unroll
                    for (int ks = 0; ks < 4; ++ks) { trn[ks] = __builtin_nontemporal_load((const bf16x8*)(yb + 16 * ks)); tin[ks] = __builtin_nontemporal_load((const bf16x8*)(yb + 1024 * 64 + 16 * ks)); }
                }
            }
            f32x16 U[2], V[2];
            const int nkt = (k1 == 32) ? 1 : 2;
#pragma unroll
            for (int kt = 0; kt < 2; ++kt) {
                if (kt >= nkt) break;
                const f32x16 z16 = {0.f, 0.f, 0.f, 0.f, 0.f, 0.f, 0.f, 0.f, 0.f, 0.f, 0.f, 0.f, 0.f, 0.f, 0.f, 0.f};
#pragma unroll
                for (int ks = 0; ks < 4; ++ks) {
                    U[kt] = __builtin_amdgcn_mfma_f32_32x32x16_bf16(trf[ks], f.C[kt][ks], ks == 0 ? z16 : U[kt], 0, 0, 0);
                    U[kt] = __builtin_amdgcn_mfma_f32_32x32x16_bf16(ntf[ks], f.S[kt][ks], U[kt], 0, 0, 0);
                    V[kt] = __builtin_amdgcn_mfma_f32_32x32x16_bf16(tif[ks], f.C[kt][ks], ks == 0 ? z16 : V[kt], 0, 0, 0);
                    V[kt] = __builtin_amdgcn_mfma_f32_32x32x16_bf16(trf[ks], f.S[kt][ks], V[kt], 0, 0, 0);
                }
            }
#pragma unroll
            for (int kt = 0; kt < 2; ++kt) {
                if (kt >= nkt) break;
#pragma unroll
                for (int i = 0; i < 4; ++i) {
                    LAS unsigned* sp = stg + (r32 + 32 * kt) * 33 + ((32 * sub + 8 * i + 4 * hi) >> 1);
                    sp[0] = pk2(U[kt][4 * i], U[kt][4 * i + 1]); sp[1] = pk2(U[kt][4 * i + 2], U[kt][4 * i + 3]);
                    sp[64 * 33] = pk2(V[kt][4 * i], V[kt][4 * i + 1]); sp[64 * 33 + 1] = pk2(V[kt][4 * i + 2], V[kt][4 * i + 3]);
                }
            }
        }
        asm volatile("s_waitcnt lgkmcnt(0)" ::: "memory");
#pragma unroll
        for (int it = 0; it < 8; ++it) {
            const int part = it >> 2, row = (it & 3) * 8 + (c.lane >> 3), chunk = c.lane & 7;
            const LAS unsigned* sp = stg + (part * 64 + row) * 33 + chunk * 4;
            u32x4 w; w.x = sp[0]; w.y = sp[1]; w.z = sp[2]; w.w = sp[3];
            *(u32x4*)((part ? VB : UB) + ((size_t)bat * 2048 + k1 + 64 * row) * D + c0 + chunk * 8) = w;
        }
        if (k1 >= 1 && k1 < 32) {
#pragma unroll
            for (int it = 0; it < 8; ++it) {
                const int part = it >> 2, row = 32 + (it & 3) * 8 + (c.lane >> 3), chunk = c.lane & 7;
                const LAS unsigned* sp = stg + (part * 64 + row) * 33 + chunk * 4;
                const unsigned sg = part ? 0x80008000u : 0u;
                u32x4 w; w.x = sp[0] ^ sg; w.y = sp[1] ^ sg; w.z = sp[2] ^ sg; w.w = sp[3] ^ sg;
                *(u32x4*)((part ? VB : UB) + ((size_t)bat * 2048 + (64 - k1) + 64 * (63 - row)) * D + c0 + chunk * 8) = w;
            }
        }
        if (k1 == 0 && c.lane < 8) {
            const LAS unsigned* sp = stg + 32 * 33 + c.lane * 4;
            u32x4 w; w.x = sp[0]; w.y = sp[1]; w.z = sp[2]; w.w = sp[3];
            *(u32x4*)(U2048 + (size_t)bat * D + c0 + c.lane * 8) = w;
        }
        asm volatile("s_waitcnt lgkmcnt(0)" ::: "memory");
    }
#undef F2_ADDR
#undef F2_BAT
#undef F2_K1
}

DEVI void router_tables(LAS unsigned char* lds, const float* g, const float* rw, int t0, int nth) {
    constexpr int WROW = 1032;
    LAS unsigned short* whi = (LAS unsigned short*)lds; LAS unsigned short* wlo = whi + 32 * WROW;
    for (int it = t0; it < 8192; it += nth) {
        const f32x4 w = *((const f32x4*)rw + it); const int d = it >> 3, e0 = (it & 7) * 4; const float gd = g[d];
#pragma unroll
        for (int j = 0; j < 4; ++j) { const float v = w[j] * gd; const unsigned h = f2bf(v); const unsigned l = f2bf(v - __builtin_bit_cast(float, h << 16));
            const int e = e0 + j, slot = (e & 1) * 16 + (e >> 1); whi[slot * WROW + d] = (unsigned short)h; wlo[slot * WROW + d] = (unsigned short)l; }
    }
}
struct RouterTablesWork { LAS unsigned char* lds; const float* g; const float* rw; DEVI void operator()() const { router_tables(lds, g, rw, opaque_tid() - 64, 448); } };
template <bool F8>
DEVI void router_phase(const Ctx& c0, const bf16_t* X, const float* g, const float* rw, const float* rb, unsigned char* HN, int* idx, float* gate, int* epos, unsigned* cnt, int* etok, bool tables_ready) {
    const Ctx c = refresh(c0);
    constexpr int WROW = 1032;
    LAS unsigned short* whi = (LAS unsigned short*)c.lds; LAS unsigned short* wlo = whi + 32 * WROW;
    LAS int* hist = (LAS int*)(c.lds + LDSCTL_OFF + LC_HIST);
    if (!tables_ready) router_tables(c.lds, g, rw, c.tid, 512);
    if (c.tid < 32) hist[c.tid] = 0;
    __syncthreads();
    f32x4 gg[2][2];
#pragma unroll
    for (int jj = 0; jj < 2; ++jj) { gg[jj][0] = *(const f32x4*)(g + 512 * jj + 8 * c.lane); gg[jj][1] = *(const f32x4*)(g + 512 * jj + 8 * c.lane + 4); }
    const int tl = c.lane & 15, q = c.lane >> 4;
    const bool hi32 = c.lane >= 32;
    for (int ci = c.v; ci < T / 128; ci += c.G) {
        const int t0 = ci * 128 + c.wave * 16;
        const bf16_t* xp = X + (size_t)(t0 + tl) * D + 8 * q;
        const LAS unsigned short* wp = whi + tl * WROW + 8 * q;
        f32x4 acc0 = {0.f, 0.f, 0.f, 0.f}, acc1 = {0.f, 0.f, 0.f, 0.f};
        float ss = 0.f;
        u32x4 xa[4], xb[4];
#pragma unroll
        for (int u = 0; u < 4; ++u) xa[u] = *(const u32x4*)(xp + 32 * u);
#pragma unroll 1
        for (int jb = 0; jb < 8; ++jb) {
            if (jb < 7) {
#pragma unroll
                for (int u = 0; u < 4; ++u) xb[u] = *(const u32x4*)(xp + 32 * (4 * (jb + 1) + u));
            }
#pragma unroll
            for (int u = 0; u < 4; ++u) {
                const u32x4 xw = xa[u]; const int U = 4 * jb + u;
                const float xv[8] = {bflo(xw.x), bfhi(xw.x), bflo(xw.y), bfhi(xw.y), bflo(xw.z), bfhi(xw.z), bflo(xw.w), bfhi(xw.w)};
#pragma unroll
                for (int i = 0; i < 8; ++i) ss += xv[i] * xv[i];
                const bf16x8 xb8 = __builtin_bit_cast(bf16x8, xw);
                const bf16x8 h0 = *(const LAS bf16x8*)(wp + 32 * U), h1 = *(const LAS bf16x8*)(wp + 16 * WROW + 32 * U);
                const bf16x8 l0 = *(const LAS bf16x8*)(wp + 32 * WROW + 32 * U), l1 = *(const LAS bf16x8*)(wp + 48 * WROW + 32 * U);
                acc0 = __builtin_amdgcn_mfma_f32_16x16x32_bf16(h0, xb8, acc0, 0, 0, 0); acc1 = __builtin_amdgcn_mfma_f32_16x16x32_bf16(h1, xb8, acc1, 0, 0, 0);
                acc0 = __builtin_amdgcn_mfma_f32_16x16x32_bf16(l0, xb8, acc0, 0, 0, 0); acc1 = __builtin_amdgcn_mfma_f32_16x16x32_bf16(l1, xb8, acc1, 0, 0, 0);
            }
#pragma unroll
            for (int u = 0; u < 4; ++u) xa[u] = xb[u];
        }
        ss += xor_f32<16>(ss, hi32); ss += xor_f32<32>(ss, hi32);
        const float r = rsqrtf(ss * (1.0f / D) + RMS_EPS);
        float lv[8];
#pragma unroll
        for (int rr = 0; rr < 4; ++rr) { lv[2 * rr] = acc0[rr] * r + rb[2 * (4 * q + rr)]; lv[2 * rr + 1] = acc1[rr] * r + rb[2 * (4 * q + rr) + 1]; }
        float topv[4]; int topi[4];
#pragma unroll
        for (int k = 0; k < 4; ++k) {
            float bv = lv[0]; int bi = 8 * q;
#pragma unroll
            for (int n = 1; n < 8; ++n) if (lv[n] > bv) { bv = lv[n]; bi = 8 * q + n; }
#define AM_STEP(O) { const float ov = xor_f32<O>(bv, hi32); const int oi = (int)xor_u32<O>((unsigned)bi, hi32); if (ov > bv || (ov == bv && oi < bi)) { bv = ov; bi = oi; } }
            AM_STEP(16) AM_STEP(32)
#undef AM_STEP
            topv[k] = bv; topi[k] = bi;
#pragma unroll
            for (int n = 0; n < 8; ++n) if (bi == 8 * q + n) lv[n] = -INFINITY;
        }
        float ex[4], sum = 0.f;
#pragma unroll
        for (int k = 0; k < 4; ++k) { ex[k] = __expf(topv[k] - topv[0]); sum += ex[k]; }
        int rk[4] = {0, 0, 0, 0};
        if (c.lane < 16) {
            const int t = t0 + tl; const float inv = 1.0f / sum;
#pragma unroll
            for (int k = 0; k < 4; ++k) { idx[t * 4 + k] = topi[k]; gate[t * 4 + k] = ex[k] * inv; rk[k] = __hip_atomic_fetch_add(&hist[topi[k]], 1, __ATOMIC_RELAXED, __HIP_MEMORY_SCOPE_WORKGROUP); }
        }
#pragma unroll 8
        for (int i = 0; i < 16; ++i) {
            const float ri = __builtin_bit_cast(float, __builtin_amdgcn_readlane(__builtin_bit_cast(int, r), i));
            const int t = t0 + i;
#pragma unroll
            for (int jj = 0; jj < 2; ++jj) {
                const u32x4 xw = *(const u32x4*)(X + (size_t)t * D + 512 * jj + 8 * c.lane);
                const f32x4 h0 = (f32x4){bflo(xw.x), bfhi(xw.x), bflo(xw.y), bfhi(xw.y)} * ri * gg[jj][0], h1 = (f32x4){bflo(xw.z), bfhi(xw.z), bflo(xw.w), bfhi(xw.w)} * ri * gg[jj][1];
                if (F8) { u32x2 w; w.x = pk4f8(h0[0], h0[1], h0[2], h0[3]); w.y = pk4f8(h1[0], h1[1], h1[2], h1[3]); *(u32x2*)(HN + (size_t)t * D + 512 * jj + 8 * c.lane) = w; }
                else { u32x4 w; w.x = pk2(h0[0], h0[1]); w.y = pk2(h0[2], h0[3]); w.z = pk2(h1[0], h1[1]); w.w = pk2(h1[2], h1[3]); *(u32x4*)(HN + ((size_t)t * D + 512 * jj + 8 * c.lane) * 2) = w; }
            }
        }
        __syncthreads();
        LAS int* hbase = (LAS int*)(c.lds + LDSCTL_OFF + LC_PST);
        if (c.tid < 32) { const int h = hist[c.tid]; hbase[c.tid] = (int)__hip_atomic_fetch_add(&cnt[c.tid], (unsigned)h, RLX_AGENT); hist[c.tid] = 0; }
        __syncthreads();
        if (c.lane < 16) {
            const int t = t0 + tl;
#pragma unroll
            for (int k = 0; k < 4; ++k) { const int e = topi[k], pp = hbase[e] + rk[k]; etok[e * ETOK_E + pp] = t; epos[t * 4 + k] = pp; }
        }
        __syncthreads();
    }
}

DEVI void moe_plan(const Ctx& c0, const unsigned* cnt) {
    const Ctx c = refresh(c0);
    LAS int* pst = (LAS int*)(c.lds + LDSCTL_OFF + LC_PST); LAS int* ntl = (LAS int*)(c.lds + LDSCTL_OFF + LC_NT); LAS int* tile_e = (LAS int*)(c.lds + LDSCTL_OFF + LC_TILEE);
    if (c.tid < 64) {
        const int e = c.tid; const int cn = (e < NE) ? (int)__hip_atomic_load(&cnt[e], RLX_AGENT) : 0;
        const int padded = ((cn + MT - 1) / MT) * MT;
        if (e < NE) pst[e] = padded;
        asm volatile("s_waitcnt lgkmcnt(0)" ::: "memory");
        int st = 0;
        for (int j = 0; j < NE; ++j) { const int pj = pst[j]; st += (j < e) ? pj : 0; }
        asm volatile("s_waitcnt lgkmcnt(0)" ::: "memory");
        const int incl = st + padded;
        if (e < NE) { pst[e] = st; for (int i = st / MT; i < incl / MT; ++i) tile_e[i] = e; if (e == NE - 1) ntl[0] = incl / MT; }
    }
    __syncthreads();
}

template <bool FINAL>
DEVI void combine_phase(const Ctx& c0, bf16_t* X, const bf16_t* Y, const float* gate, const int* idx, const int* epos, const float* gn, unsigned char* HN8A, float* OUT) {
    const Ctx c = refresh(c0);
    const int gw = c.v * 8 + c.wave, NGW = c.G * 8;
    const LAS int* pstl = (const LAS int*)(c.lds + LDSCTL_OFF + LC_PST);
    f32x4 gg[2][2];
#pragma unroll
    for (int jj = 0; jj < 2; ++jj) { gg[jj][0] = *(const f32x4*)(gn + 512 * jj + 8 * c.lane); gg[jj][1] = *(const f32x4*)(gn + 512 * jj + 8 * c.lane + 4); }
    for (int blk = gw; blk < T / 16; blk += NGW) {
        const int t0 = blk * 16;
        const int myslot = pstl[idx[t0 * 4 + c.lane]] + epos[t0 * 4 + c.lane]; const float mygate = gate[t0 * 4 + c.lane];
#pragma unroll 1
        for (int i = 0; i < 16; i += 2) {
            f32x4 v[2][2][2]; u32x4 y[2][4][2];
#pragma unroll
            for (int u = 0; u < 2; ++u) {
                const bf16_t* xr = X + (size_t)(t0 + i + u) * D + 8 * c.lane;
#pragma unroll
                for (int jj = 0; jj < 2; ++jj) { const u32x4 xw = *(const u32x4*)(xr + 512 * jj); v[u][jj][0] = (f32x4){bflo(xw.x), bfhi(xw.x), bflo(xw.y), bfhi(xw.y)}; v[u][jj][1] = (f32x4){bflo(xw.z), bfhi(xw.z), bflo(xw.w), bfhi(xw.w)}; }
#pragma unroll
                for (int k = 0; k < 4; ++k) {
                    const int slot = __builtin_amdgcn_readlane(myslot, (i + u) * 4 + k);
                    const unsigned char* yr = (const unsigned char*)Y + (size_t)slot * D + 8 * c.lane;
                    const u32x2 ya = __builtin_nontemporal_load((const u32x2*)yr), yb = __builtin_nontemporal_load((const u32x2*)(yr + 512));
                    y[u][k][0] = (u32x4){ya.x, ya.y, 0u, 0u}; y[u][k][1] = (u32x4){yb.x, yb.y, 0u, 0u};
                }
            }
#pragma unroll
            for (int u = 0; u < 2; ++u) {
                const int t = t0 + i + u;
#pragma unroll
                for (int k = 0; k < 4; ++k) {
                    const float gk = __builtin_bit_cast(float, __builtin_amdgcn_readlane(__builtin_bit_cast(int, mygate), (i + u) * 4 + k));
#pragma unroll
                    for (int jj = 0; jj < 2; ++jj) {
                        const u32x4 yy = y[u][k][jj];
                        const f32x2 p0 = __builtin_amdgcn_cvt_pk_f32_fp8((int)yy.x, false), p1 = __builtin_amdgcn_cvt_pk_f32_fp8((int)yy.x, true), p2 = __builtin_amdgcn_cvt_pk_f32_fp8((int)yy.y, false), p3 = __builtin_amdgcn_cvt_pk_f32_fp8((int)yy.y, true);
                        v[u][jj][0].x += gk * p0.x; v[u][jj][0].y += gk * p0.y; v[u][jj][0].z += gk * p1.x; v[u][jj][0].w += gk * p1.y;
                        v[u][jj][1].x += gk * p2.x; v[u][jj][1].y += gk * p2.y; v[u][jj][1].z += gk * p3.x; v[u][jj][1].w += gk * p3.y;
                    }
                }
                float s = 0.f;
#pragma unroll
                for (int jj = 0; jj < 2; ++jj)
#pragma unroll
                    for (int h = 0; h < 2; ++h) { const f32x4 a = v[u][jj][h]; s += a.x * a.x + a.y * a.y + a.z * a.z + a.w * a.w; }
                const float r = rsqrtf(wave_sum(s) * (1.0f / D) + RMS_EPS);
                bf16_t* xr = X + (size_t)t * D + 8 * c.lane;
#pragma unroll
                for (int jj = 0; jj < 2; ++jj) {
                    if (FINAL) { const f32x4 a0 = v[u][jj][0] * r * gg[jj][0], a1 = v[u][jj][1] * r * gg[jj][1]; float* o = OUT + (size_t)t * D + 8 * c.lane + 512 * jj; *(f32x4*)o = a0; *(f32x4*)(o + 4) = a1; }
                    else { const f32x4 x0 = v[u][jj][0], x1 = v[u][jj][1]; u32x4 xw; xw.x = pk2(x0.x, x0.y); xw.y = pk2(x0.z, x0.w); xw.z = pk2(x1.x, x1.y); xw.w = pk2(x1.z, x1.w); *(u32x4*)(xr + 512 * jj) = xw;
                        const f32x4 a0 = x0 * r * gg[jj][0], a1 = x1 * r * gg[jj][1];
                        u32x2 hw; hw.x = pk4f8(a0.x, a0.y, a0.z, a0.w); hw.y = pk4f8(a1.x, a1.y, a1.z, a1.w); *(u32x2*)(HN8A + (size_t)t * D + 8 * c.lane + 512 * jj) = hw; }
                }
            }
        }
    }
}

constexpr int AT_KOFF = 0, AT_VOFF = 49152, AT_VS = 776;
DEVI void attn_phase(const Ctx& c0, const bf16_t* Q, const bf16_t* Kb, const bf16_t* VT, const float* sink, bf16_t* O) {
    const Ctx c = refresh(c0);
    LAS unsigned char* lds = c.lds;
    const int r32 = c.lane & 31, hi = c.lane >> 5;
    u32x4 kpre[6], vpre[6];
    auto img_issue = [&](int Lx) {
        const int t_ = opaque_tid(), b_ = Lx >> 7, kv_ = (Lx >> 5) & 3, qb_ = Lx & 31, kp0_ = (qb_ - 1) * 128;
        const bf16_t* kb_ = Kb + ((long)b_ * SEQ + kp0_ + (t_ >> 3)) * 256 + kv_ * 64 + (t_ & 7) * 8;
        const bf16_t* vb_ = VT + (long)(kv_ * 64 + (t_ >> 3)) * T + (long)b_ * SEQ + kp0_ + 8 * (t_ & 7);
#pragma unroll
        for (int i = 0; i < 6; ++i) if (!((i >> 1) == 0 && qb_ == 0) && !((i >> 1) == 2 && qb_ == 31)) { kpre[i] = *(const u32x4*)(kb_ + i * 64 * 256); vpre[i] = *(const u32x4*)(vb_ + i * 64); }
    };
    if (c.v < 1024) img_issue(c.v);
    for (int L = c.v; L < 1024; L += c.G) {
        const int b = L >> 7, kv = (L >> 5) & 3, qb = L & 31;
        __syncthreads();
        { const int t_ = opaque_tid(), row0 = t_ >> 3, cc = t_ & 7;
          LAS unsigned char* kl = lds + AT_KOFF + row0 * 128 + ((cc ^ ((row0 >> 1) & 7)) << 4);
          LAS unsigned char* vl = lds + AT_VOFF + row0 * AT_VS + cc * 16;
#pragma unroll
          for (int i = 0; i < 6; ++i) if (!((i >> 1) == 0 && qb == 0) && !((i >> 1) == 2 && qb == 31)) {
              *(LAS u32x4*)(kl + i * 8192) = kpre[i];
              LAS u32x2* dp = (LAS u32x2*)(vl + i * 128); dp[0] = (u32x2){vpre[i].x, vpre[i].y}; dp[1] = (u32x2){vpre[i].z, vpre[i].w}; } }
        __syncthreads();
        const int g = c.wave >> 1, hq = kv * 4 + g;
        const float snk = sink[hq];
        const int jlo = (qb == 0) ? 1 : 0, jhi = (qb == 31) ? 2 : 3;
        for (int qc = 0; qc < 2; ++qc) {
            const int ql0 = (c.wave & 1) * 64 + qc * 32;
            const size_t trow = (size_t)b * SEQ + qb * 128 + ql0 + r32;
            bf16x8 qf[4];
#pragma unroll
            for (int ks = 0; ks < 4; ++ks) qf[ks] = *(const bf16x8*)(Q + trow * D + hq * 64 + ks * 16 + hi * 8);
            float m = snk * 1.4426950408889634f, l = 1.0f;
            f32x16 o0, o1;
#pragma unroll
            for (int i = 0; i < 16; ++i) { o0[i] = 0.f; o1[i] = 0.f; }
            const int qc4 = ql0 >> 5;
            for (int jb = jlo; jb < jhi; ++jb) {
                f32x16 s[4];
                __builtin_amdgcn_s_setprio(1);
#pragma unroll
                for (int kt = 0; kt < 4; ++kt) {
                    const bool act = (jb == 1) || (jb == 0 ? kt >= qc4 : kt <= qc4);
                    if (act) {
                        const int row = jb * 128 + kt * 32 + r32;
#pragma unroll
                        for (int ks = 0; ks < 4; ++ks) {
                            const bf16x8 kf = *(const LAS bf16x8*)(lds + AT_KOFF + row * 128 + (((2 * ks + hi) ^ ((row >> 1) & 7)) << 4));
                            if (ks == 0) s[kt] = __builtin_amdgcn_mfma_f32_32x32x16_bf16(kf, qf[0], (f32x16){0.f, 0.f, 0.f, 0.f, 0.f, 0.f, 0.f, 0.f, 0.f, 0.f, 0.f, 0.f, 0.f, 0.f, 0.f, 0.f}, 0, 0, 0);
                            else s[kt] = __builtin_amdgcn_mfma_f32_32x32x16_bf16(kf, qf[ks], s[kt], 0, 0, 0);
                        }
                    }
                }
                __builtin_amdgcn_s_setprio(0);
                float mx = -1e30f;
#pragma unroll
                for (int kt = 0; kt < 4; ++kt) {
                    const bool act = (jb == 1) || (jb == 0 ? kt >= qc4 : kt <= qc4);
                    if (act) {
                        if (jb != 1 && kt == qc4) {
                            const int sg = (jb == 0) ? 1 : -1;
                            int tq = sg * (4 * hi - r32); asm volatile("" : "+v"(tq));
#pragma unroll
                            for (int i = 0; i < 16; ++i) {
                                const int kc = (i & 3) + 8 * (i >> 2);
                                const float sv = (sg * kc + tq >= 0) ? s[kt][i] : -1e30f;
                                s[kt][i] = sv; mx = fmaxf(mx, sv);
                            }
                        } else {
#pragma unroll
                            for (int i = 0; i < 16; ++i) mx = fmaxf(mx, s[kt][i]);
                        }
                    }
                }
                mx = max32(mx);
                const float mn = fmaxf(m, mx), alpha = __builtin_amdgcn_exp2f(m - mn);
                float ps = 0.f;
#pragma unroll
                for (int kt = 0; kt < 4; ++kt) {
                    const bool act = (jb == 1) || (jb == 0 ? kt >= qc4 : kt <= qc4);
                    if (act) {
#pragma unroll
                        for (int i = 0; i < 16; ++i) { const float pv = __builtin_amdgcn_exp2f(s[kt][i] - mn); s[kt][i] = pv; ps += pv; }
                    }
                }
                ps = sum32(ps);
                l = l * alpha + ps; m = mn;
#pragma unroll
                for (int i = 0; i < 16; ++i) { o0[i] *= alpha; o1[i] *= alpha; }
                __builtin_amdgcn_s_setprio(1);
#pragma unroll
                for (int kt = 0; kt < 4; ++kt) {
                    const bool act = (jb == 1) || (jb == 0 ? kt >= qc4 : kt <= qc4);
                    if (act) {
#pragma unroll
                        for (int s2 = 0; s2 < 2; ++s2) {
                            union { bf16x8 v; unsigned w[4]; } pf;
#pragma unroll
                            for (int j = 0; j < 4; ++j) pf.w[j] = pk2(s[kt][8 * s2 + 2 * j], s[kt][8 * s2 + 2 * j + 1]);
                            const int key = jb * 128 + kt * 32 + s2 * 16 + 4 * hi;
#pragma unroll
                            for (int dt = 0; dt < 2; ++dt) {
                                const LAS unsigned char* vp = lds + AT_VOFF + (dt * 32 + r32) * AT_VS + key * 2;
                                union { bf16x8 v; u32x2 h[2]; } vf;
                                vf.h[0] = *(const LAS u32x2*)vp; vf.h[1] = *(const LAS u32x2*)(vp + 16);
                                if (dt == 0) o0 = __builtin_amdgcn_mfma_f32_32x32x16_bf16(vf.v, pf.v, o0, 0, 0, 0);
                                else o1 = __builtin_amdgcn_mfma_f32_32x32x16_bf16(vf.v, pf.v, o1, 0, 0, 0);
                            }
                        }
                    }
                }
                __builtin_amdgcn_s_setprio(0);
            }
            const float inv = 1.0f / l;
            unsigned char* op = (unsigned char*)O + trow * D + hq * 64 + 32 * hi;
            u32x4 w0, w1;
#pragma unroll
            for (int i = 0; i < 4; ++i) { w0[i] = pk4f8(o0[4 * i] * inv, o0[4 * i + 1] * inv, o0[4 * i + 2] * inv, o0[4 * i + 3] * inv); w1[i] = pk4f8(o1[4 * i] * inv, o1[4 * i + 1] * inv, o1[4 * i + 2] * inv, o1[4 * i + 3] * inv); }
            *(u32x4*)op = w0; *(u32x4*)(op + 16) = w1;
            if (qc == 0 && L + c.G < 1024) img_issue(L + c.G);
        }
    }
}

struct Args { In in; float* out; unsigned char* ws; int ph_lo, ph_hi, li, pad; };

__global__ void __launch_bounds__(512, 2) mk_fwd(Args args) {
    extern __shared__ __attribute__((aligned(16))) unsigned char lds_raw[];
    Ctx c; c.lds = (LAS unsigned char*)lds_raw;
    c.tid = threadIdx.x; c.lane = c.tid & 63; c.wave = __builtin_amdgcn_readfirstlane(c.tid >> 6);
    c.G = gridDim.x; { const int bx = blockIdx.x; c.v = (c.G % 8 == 0) ? (bx % 8) * (c.G / 8) + bx / 8 : bx; }
    unsigned char* ws = args.ws;
    for (int u = c.tid; u < (LDS_BYTES - LDSCTL_OFF) / 4; u += 512) ((LAS unsigned*)(c.lds + LDSCTL_OFF))[u] = 0u;
    __syncthreads();
    if (c.tid == 0) {
        LAS unsigned long long* pt = (LAS unsigned long long*)(c.lds + LDSCTL_OFF + LC_PTRS);
#define PT(i) pt[i] = (unsigned long long)args.in.p[i];
        PT(0) PT(1) PT(2) PT(3) PT(4) PT(5) PT(6) PT(7) PT(8) PT(9) PT(10) PT(11) PT(12) PT(13) PT(14) PT(15) PT(16)
#undef PT
        pt[17] = (unsigned long long)args.out;
    }
    if (MK_N_LAUNCHES == 1) (void)xcd_barrier_post((unsigned*)(ws + WS_CTL) + CW_BAR, (volatile LAS unsigned*)(c.lds + LDSCTL_OFF + LC_BARST));
    __syncthreads();
    const int lo = args.ph_lo, hi = args.ph_hi;
#ifndef PHMASK
#define PHMASK 0xFFFF
#endif
#define IN(k) (((PHMASK >> ((k) > 10 ? (k) - 8 : (k))) & 1) && lo <= (k) && (k) < hi)
#define SEAM(k) do { if (IN(k) && IN((k) + 1)) { XcdBarrier bar_; bar_.bar = (unsigned*)(ws + WS_CTL) + CW_BAR; bar_.x = xb_xcc_id(); bar_.st = (volatile LAS unsigned*)(c.lds + LDSCTL_OFF + LC_BARST); xcd_barrier(bar_); } } while (0)
#define SEAMW(k, work) do { if (IN(k) && IN((k) + 1)) { XcdBarrier bar_; bar_.bar = (unsigned*)(ws + WS_CTL) + CW_BAR; bar_.x = xb_xcc_id(); bar_.st = (volatile LAS unsigned*)(c.lds + LDSCTL_OFF + LC_BARST); xcd_barrier(bar_, work); } } while (0)
#define SEAMC(k, sm) do { if (MK_N_LAUNCHES == 1) { const ConvWork cw_{c.lds, ws, c.v, c.G, sm}; SEAMW(k, cw_); } else SEAM(k); } while (0)
#define GBARC(sm) do { XcdBarrier bar_; bar_.bar = (unsigned*)(ws + WS_CTL) + CW_BAR; bar_.x = xb_xcc_id(); bar_.st = (volatile LAS unsigned*)(c.lds + LDSCTL_OFF + LC_BARST); if (MK_N_LAUNCHES == 1) { const ConvWork cw_{c.lds, ws, c.v, c.G, sm}; xcd_barrier(bar_, cw_); } else xcd_barrier(bar_); } while (0)
#define GBAR() do { XcdBarrier bar_; bar_.bar = (unsigned*)(ws + WS_CTL) + CW_BAR; bar_.x = xb_xcc_id(); bar_.st = (volatile LAS unsigned*)(c.lds + LDSCTL_OFF + LC_BARST); xcd_barrier(bar_); } while (0)
#ifndef DUPMASK
#define DUPMASK 0
#endif
#define RUNPH(k, ...) do { if (IN(k)) { __VA_ARGS__ if ((DUPMASK >> (k)) & 1) { GBAR(); __VA_ARGS__ } } } while (0)
#define XOUT ((float*)inptr(c, 17))
#define XRES ((bf16_t*)(ws + WS_XB))
#define WSP(T_, off) ((T_*)(ws + (off)))
    const LAS int* tile_e = (const LAS int*)(c.lds + LDSCTL_OFF + LC_TILEE); const LAS int* ntl = (const LAS int*)(c.lds + LDSCTL_OFF + LC_NT);

    RUNPH(0, { p0_prologue(c, ws); });
    SEAMC(0, 0);
    RUNPH(1, {
        F64Frags f64; { const Ctx cf = refresh(c); make_f64(cf, f64); __syncthreads(); }
        fft1_phase(c, f64, WSP(bf16_t, WS_HT), WSP(float, WS_TW), WSP(bf16_t, WS_Y2));
        GBARC(1);
        fft2_phase(c, f64, WSP(bf16_t, WS_Y2), WSP(bf16_t, WS_UB), WSP(bf16_t, WS_VB), WSP(bf16_t, WS_U2048));
    });
    SEAMC(1, 2);
    RUNPH(2, {
        {
            SchedRows<4> S{(const char*)(ws + WS_UB), (const char*)(ws + WS_WP), D, 256, c.G, c.v};
            EpiF32 E{WSP(bf16_t, WS_PU)};
            pg8::gemm_phase<EpiF32, SchedRows<4>, true>(c.lds, D, S, E);
        }
        asm volatile("s_waitcnt vmcnt(0)" ::: "memory"); __syncthreads();
        {
            SchedRows<4> S{(const char*)(ws + WS_VB), (const char*)(ws + WS_WP) + (size_t)D * D * 2, D, 256, c.G, c.v};
            EpiMirror E{inptr(c, 0), XRES, inptr(c, 4), WSP(bf16_t, WS_PU)};
            pg8::gemm_phase<EpiMirror, SchedRows<4>, true>(c.lds, D, S, E);
        }
        {
            const Ctx cc = refresh(c);
            const bf16_t* U2 = WSP(bf16_t, WS_U2048); const bf16_t* Wc = WSP(bf16_t, WS_WP); const float* xin = inptr(c, 0); const float* bo = inptr(c, 4); bf16_t* Xo = XRES;
            for (int it0 = cc.v * 8 + cc.wave; it0 < BATCH * D; it0 += 4 * cc.G * 8) {
                u32x4 uu[4][2], ww[4][2];
_Pragma("unroll")
                for (int k = 0; k < 4; ++k) { const int it = it0 + k * cc.G * 8; if (it < BATCH * D) { const int bat = it >> 10, n = it & 1023;
                    uu[k][0] = *((const u32x4*)(U2 + (size_t)bat * D) + cc.lane); uu[k][1] = *((const u32x4*)(U2 + (size_t)bat * D) + 64 + cc.lane);
                    ww[k][0] = *((const u32x4*)(Wc + (size_t)n * D) + cc.lane); ww[k][1] = *((const u32x4*)(Wc + (size_t)n * D) + 64 + cc.lane); } }
_Pragma("unroll")
                for (int k = 0; k < 4; ++k) { const int it = it0 + k * cc.G * 8; if (it < BATCH * D) { const int bat = it >> 10, n = it & 1023;
                    float a = 0.f;
_Pragma("unroll")
                    for (int h = 0; h < 2; ++h) { const u32x4 u4 = uu[k][h], w4 = ww[k][h];
                        a += bflo(u4.x) * bflo(w4.x) + bfhi(u4.x) * bfhi(w4.x) + bflo(u4.y) * bflo(w4.y) + bfhi(u4.y) * bfhi(w4.y) + bflo(u4.z) * bflo(w4.z) + bfhi(u4.z) * bfhi(w4.z) + bflo(u4.w) * bflo(w4.w) + bfhi(u4.w) * bfhi(w4.w); }
                    a = wave_sum(a);
                    if (cc.lane == 0) { const size_t o = ((size_t)bat * SEQ + 2048) * D + n; Xo[o] = (bf16_t)f2bf(xin[o] + a + bo[n]); } } }
            }
        }
    });
    { const RouterTablesWork rt_{c.lds, inptr(c, 2) + 0 * D, inptr(c, 10) + (size_t)0 * D * NE}; SEAMW(2, rt_); }
#undef CNT
#define CNT ((unsigned*)(ws + WS_CTL) + CW_CNT + 64 * 0)
    if (IN(3)) router_phase<F8L0>(c, XRES, inptr(c, 2) + 0 * D, inptr(c, 10) + (size_t)0 * D * NE, inptr(c, 11) + 0 * NE, WSP(unsigned char, WS_HN8), WSP(int, WS_IDX), WSP(float, WS_GATE), WSP(int, WS_SLOTOF), CNT, WSP(int, WS_XS) + 0 * NE * ETOK_E, MK_N_LAUNCHES == 1);
    SEAMC(3, 3);
    RUNPH(3 + 2, {
        moe_plan(c, CNT);
        moe_stagger<8>(c.G, c.v, __builtin_amdgcn_readfirstlane(ntl[0]));
        typedef SchedMoEG<8, 2048, 128, F8L0 ? 1024 : 2048> SM;
        SM S{(const char*)(ws + WS_HN8), (const char*)(ws + WS_WGU + (size_t)0 * 128 * MiB), tile_e, WSP(int, WS_XS) + 0 * NE * ETOK_E, (const LAS int*)(c.lds + LDSCTL_OFF + LC_PST), __builtin_amdgcn_readfirstlane(ntl[0]), c.G, c.v};
        EpiGLU<F8L0> E{WSP(unsigned char, WS_HID), inptr(c, 13) + (size_t)0 * NE * 2048};
#ifdef PROBE_ABL
        pg8::gemm_phase<EpiGLU<F8L0>, SM, true, F8L0, PROBE_ABL, true>(c.lds, F8L0 ? D / 2 : D, S, E); GBAR();
#endif
        pg8::gemm_phase<EpiGLU<F8L0>, SM, true, F8L0, 0, true>(c.lds, F8L0 ? D / 2 : D, S, E);
        moe_tail<8>(c, ws, __builtin_amdgcn_readfirstlane(ntl[0]), 0, 2304, 96, 3);
    });
    SEAMC(3 + 2, 4);
    RUNPH(3 + 3, {
        if (MK_N_LAUNCHES != 1) moe_plan(c, CNT);
        moe_stagger<4>(c.G, c.v, __builtin_amdgcn_readfirstlane(ntl[0]));
        typedef SchedMoE<4, 1024, 256, true, F8L0 ? 1024 : 2048> SM;
        SM S{(const char*)(ws + WS_HID), (const char*)(ws + WS_WD + (size_t)0 * 64 * MiB), tile_e, __builtin_amdgcn_readfirstlane(ntl[0]), c.G, c.v};
        EpiBf16<1, D, F8L0, true> E{WSP(bf16_t, WS_Y), inptr(c, 15) + (size_t)0 * NE * D};
        pg8::gemm_phase<EpiBf16<1, D, F8L0, true>, SM, true, F8L0, 0, false, F8L0>(c.lds, F8L0 ? D / 2 : D, S, E);
        moe_tail<4>(c, ws, __builtin_amdgcn_readfirstlane(ntl[0]), 2304, 6144, 160, 3);
    });
    SEAMC(3 + 3, 5);
    if (IN(7)) combine_phase<false>(c, XRES, WSP(bf16_t, WS_Y), WSP(float, WS_GATE), WSP(int, WS_IDX), WSP(int, WS_SLOTOF), inptr(c, 1) + D, WSP(unsigned char, WS_HN), nullptr);
    SEAMC(7, 6);
    RUNPH(8, {
#ifndef NO_QK
        {
            SchedRows<5> S{(const char*)(ws + WS_HN), (const char*)(ws + WS_WQKV), D / 2, 640, c.G, c.v};
            EpiQK E{WSP(bf16_t, WS_Q), WSP(bf16_t, WS_K), inptr(c, 6), WSP(float, WS_COS), nullptr};
            pg8::gemm_phase<EpiQK, SchedRows<5>, true, true>(c.lds, D / 2, S, E);
        }
#endif
#ifndef NO_VT
        {
            SchedVT S{(const char*)(ws + WS_WQKV) + (size_t)1280 * D, (const char*)(ws + WS_HN), c.G, c.v, 128};
            EpiBf16<2, T, true> E{WSP(bf16_t, WS_VT), inptr(c, 6), nullptr};
            pg8::gemm_phase<EpiBf16<2, T, true>, SchedVT, true, true>(c.lds, D / 2, S, E);
        }
#endif
    });
    SEAMC(8, 7);
    RUNPH(9, { attn_phase(c, WSP(bf16_t, WS_Q), WSP(bf16_t, WS_K), WSP(bf16_t, WS_VT), inptr(c, 7), WSP(bf16_t, WS_O)); });
    SEAMC(9, 8);
    if (IN(10)) {
        SchedRows<4> S{(const char*)(ws + WS_O), (const char*)(ws + WS_WO), D / 2, 512, c.G, c.v};
        EpiX<true> E{XRES, XRES, inptr(c, 9)};
        pg8::gemm_phase<EpiX<true>, SchedRows<4>, true, true>(c.lds, D / 2, S, E);
    }
    { const RouterTablesWork rt_{c.lds, inptr(c, 2) + 1 * D, inptr(c, 10) + (size_t)1 * D * NE}; SEAMW(10, rt_); }
#undef CNT
#define CNT ((unsigned*)(ws + WS_CTL) + CW_CNT + 64 * 1)
    if (IN(11)) router_phase<F8L1>(c, XRES, inptr(c, 2) + 1 * D, inptr(c, 10) + (size_t)1 * D * NE, inptr(c, 11) + 1 * NE, WSP(unsigned char, WS_HN8), WSP(int, WS_IDX), WSP(float, WS_GATE), WSP(int, WS_SLOTOF), CNT, WSP(int, WS_XS) + 1 * NE * ETOK_E, MK_N_LAUNCHES == 1);
    SEAMC(11, 9);
    RUNPH(11 + 2, {
        moe_plan(c, CNT);
        moe_stagger<8>(c.G, c.v, __builtin_amdgcn_readfirstlane(ntl[0]));
        typedef SchedMoEG<8, 2048, 128, F8L1 ? 1024 : 2048> SM;
        SM S{(const char*)(ws + WS_HN8), (const char*)(ws + WS_WGU + (size_t)1 * 128 * MiB), tile_e, WSP(int, WS_XS) + 1 * NE * ETOK_E, (const LAS int*)(c.lds + LDSCTL_OFF + LC_PST), __builtin_amdgcn_readfirstlane(ntl[0]), c.G, c.v};
        EpiGLU<F8L1> E{WSP(unsigned char, WS_HID), inptr(c, 13) + (size_t)1 * NE * 2048};
        pg8::gemm_phase<EpiGLU<F8L1>, SM, true, F8L1, 0, true>(c.lds, F8L1 ? D / 2 : D, S, E);
        moe_tail<8>(c, ws, __builtin_amdgcn_readfirstlane(ntl[0]), 6144, TC_N, 72, 2);
    });
    SEAM(11 + 2);
    RUNPH(11 + 3, {
        if (MK_N_LAUNCHES != 1) moe_plan(c, CNT);
        moe_stagger<4>(c.G, c.v, __builtin_amdgcn_readfirstlane(ntl[0]));
        typedef SchedMoE<4, 1024, 256, true, F8L1 ? 1024 : 2048> SM;
        SM S{(const char*)(ws + WS_HID), (const char*)(ws + WS_WD + (size_t)1 * 64 * MiB), tile_e, __builtin_amdgcn_readfirstlane(ntl[0]), c.G, c.v};
        EpiBf16<1, D, F8L1, true> E{WSP(bf16_t, WS_Y), inptr(c, 15) + (size_t)1 * NE * D};
        pg8::gemm_phase<EpiBf16<1, D, F8L1, true>, SM, true, F8L1, 0, false, F8L1>(c.lds, F8L1 ? D / 2 : D, S, E);
    });
    SEAM(11 + 3);
    if (IN(15)) combine_phase<true>(c, XRES, WSP(bf16_t, WS_Y), WSP(float, WS_GATE), WSP(int, WS_IDX), WSP(int, WS_SLOTOF), inptr(c, 16), nullptr, XOUT);
#undef IN
#undef SEAM
}

extern "C" void kernel_launch(void* const* d_in, const int* in_sizes, int n_in, void* d_out, int out_size, void* d_ws, size_t ws_size, hipStream_t stream) {
    static int grid = 0;
    if (grid == 0) {
        if (n_in != 17 || out_size != T * D || ws_size < WS_END) { fprintf(stderr, "kernel_launch: unexpected sizes n_in %d out %d ws %zu (need %zu)\n", n_in, out_size, ws_size, (size_t)WS_END); grid = -1; return; }
        int dev = 0, cus = 0, per_cu = 0;
        if (hipGetDevice(&dev) != hipSuccess || hipDeviceGetAttribute(&cus, hipDeviceAttributeMultiprocessorCount, dev) != hipSuccess) { grid = -1; return; }
        if (hipFuncSetAttribute((const void*)mk_fwd, hipFuncAttributeMaxDynamicSharedMemorySize, LDS_BYTES) != hipSuccess) { fprintf(stderr, "kernel_launch: hipFuncSetAttribute failed\n"); grid = -1; return; }
        if (hipOccupancyMaxActiveBlocksPerMultiprocessor(&per_cu, (const void*)mk_fwd, 512, LDS_BYTES) != hipSuccess || per_cu < 1) { fprintf(stderr, "kernel_launch: occupancy query says %d blocks/CU\n", per_cu); grid = -1; return; }
        (void)hipGetLastError();
        grid = cus;
    }
    if (grid < 0) return;
    (void)hipMemsetAsync((char*)d_ws + WS_CTL, 0, CTL_ZERO_BYTES, stream);
    Args a{};
    for (int i = 0; i < 17; ++i) a.in.p[i] = (const float*)d_in[i];
    a.out = (float*)d_out; a.ws = (unsigned char*)d_ws;
    if (MK_N_LAUNCHES == 1) {
        a.ph_lo = 0; a.ph_hi = NPHASE; a.li = 0;
        hipLaunchKernelGGL(mk_fwd, dim3(grid), dim3(512), LDS_BYTES, stream, a);
    } else {
        for (int li = 0; li < NPHASE; ++li) { a.ph_lo = li; a.ph_hi = li + 1; a.li = li; hipLaunchKernelGGL(mk_fwd, dim3(grid), dim3(512), LDS_BYTES, stream, a); }
    }
}
```
